# Optimizing an MI355X kernel written in HIP

```python
import math
import jax, jax.numpy as jnp
from jax import lax
import numpy as np

D_MODEL = 2048
BATCH = 2
SEQ = 8192
DEPTH = 4

HGRN_WIDTH = D_MODEL // 2
HGRN_HEAD_DIM = 128
HGRN_HEADS = HGRN_WIDTH // HGRN_HEAD_DIM
HGRN_CHUNK = 64
ATTN_HEAD_DIM = 64
ATTN_HEADS = (D_MODEL // 2) // ATTN_HEAD_DIM
ATTN_KV_HEADS = 4
ATTN_WIDTH = ATTN_HEADS * ATTN_HEAD_DIM
KV_WIDTH = ATTN_KV_HEADS * ATTN_HEAD_DIM
WINDOW = 128
CONV_WIDTH = D_MODEL // 2
CONV_K = 3
N_BUCKETS = 32
MAX_DISTANCE = 128
ALPHA = (2.0 * DEPTH) ** 0.25
BETA = (8.0 * DEPTH) ** -0.25
LN_EPS = 1e-5
RMS_EPS = 1e-6
SPLIT_SIZES = (
    HGRN_WIDTH, HGRN_WIDTH, HGRN_WIDTH, HGRN_WIDTH,
    ATTN_WIDTH, KV_WIDTH, KV_WIDTH, ATTN_WIDTH,
    CONV_WIDTH, CONV_WIDTH, CONV_WIDTH, CONV_WIDTH,
    D_MODEL, D_MODEL, D_MODEL,
)
N_IN = sum(SPLIT_SIZES)

kernel_name = "hybrid_hgrn2_swa_sink_shortconv_gated_merge"


def layer_norm(x, g, b):
    xf = x.astype(jnp.float32)
    mu = jnp.mean(xf, axis=-1, keepdims=True)
    var = jnp.mean(jnp.square(xf - mu), axis=-1, keepdims=True)
    return ((xf - mu) * lax.rsqrt(var + LN_EPS) * g.astype(jnp.float32) + b.astype(jnp.float32)).astype(x.dtype)


def t5_bucket(dist):
    max_exact = N_BUCKETS // 2
    is_small = dist < max_exact
    logd = jnp.log(jnp.maximum(dist, 1).astype(jnp.float32) / max_exact) / math.log(MAX_DISTANCE / max_exact)
    large = max_exact + (logd * (N_BUCKETS - max_exact)).astype(jnp.int32)
    large = jnp.minimum(large, N_BUCKETS - 1)
    return jnp.where(is_small, dist, large)


def band_relative_bias(rel_bias):
    i = jnp.arange(WINDOW)[:, None]
    j = jnp.arange(2 * WINDOW)[None, :]
    rel = jnp.clip(WINDOW + i - j, 0, WINDOW - 1)
    bucket = t5_bucket(rel)
    return jnp.transpose(rel_bias[bucket], (2, 0, 1)).astype(jnp.float32)


def hgrn2_mixer(q, f_logit, inp, lb):
    bsz, t, _ = q.shape
    h, d, c = HGRN_HEADS, HGRN_HEAD_DIM, HGRN_CHUNK
    nc = t // c
    qf = jax.nn.silu(q.astype(jnp.float32)) * (d ** -0.5)
    f = lb + (1.0 - lb) * jax.nn.sigmoid(f_logit.astype(jnp.float32))
    k = 1.0 - f
    g = jnp.log(f)
    v = inp.astype(jnp.float32)

    def to_chunks(a):
        return jnp.transpose(a.reshape(bsz, nc, c, h, d), (1, 0, 3, 2, 4))

    causal = jnp.tril(jnp.ones((c, c), dtype=bool))

    def step(state, chunk):
        qc, kc, vc, gc = chunk
        b = jnp.cumsum(gc, axis=2)
        inter = jnp.einsum('bhtk,bhkv->bhtv', qc * jnp.exp(b), state)
        diff = b[:, :, :, None, :] - b[:, :, None, :, :]
        decay = jnp.exp(jnp.where(causal[None, None, :, :, None], diff, -jnp.inf))
        scores = jnp.einsum('bhtk,bhsk,bhtsk->bhts', qc, kc, decay)
        intra = jnp.einsum('bhts,bhsv->bhtv', scores, vc)
        b_end = b[:, :, -1, :]
        k_to_end = kc * jnp.exp(b_end[:, :, None, :] - b)
        new_state = jnp.exp(b_end)[..., None] * state + jnp.einsum('bhsk,bhsv->bhkv', k_to_end, vc)
        return new_state, inter + intra

    s0 = jnp.zeros((bsz, h, d, d), jnp.float32)
    _, o = lax.scan(step, s0, (to_chunks(qf), to_chunks(k), to_chunks(v), to_chunks(g)))
    return jnp.transpose(o, (1, 0, 3, 2, 4)).reshape(bsz, t, h, d)


def swa_sink_attention(q, k, v, bias, sinks):
    bsz, t, _ = q.shape
    w, dh, kvh = WINDOW, ATTN_HEAD_DIM, ATTN_KV_HEADS
    grp = ATTN_HEADS // kvh
    nb = t // w
    qb = q.reshape(bsz, nb, w, kvh, grp, dh)
    kb = k.reshape(bsz, nb, w, kvh, dh)
    vb = v.reshape(bsz, nb, w, kvh, dh)

    def with_prev(a):
        prev = jnp.concatenate([jnp.zeros_like(a[:, :1]), a[:, :-1]], axis=1)
        return jnp.concatenate([prev, a], axis=2)

    kw, vw = with_prev(kb), with_prev(vb)
    s = jnp.einsum('bnqhgd,bnkhd->bhgnqk', qb, kw).astype(jnp.float32) * (dh ** -0.5)
    s = s + bias.reshape(kvh, grp, 1, w, 2 * w)
    i = jnp.arange(w)[:, None]
    j = jnp.arange(2 * w)[None, :]
    rel = w + i - j
    band = (rel >= 0) & (rel < w)
    key_pos = jnp.arange(nb)[:, None, None] * w - w + j[None]
    mask = band[None] & (key_pos >= 0)
    s = jnp.where(mask, s, -jnp.inf)
    sink = sinks.astype(jnp.float32).reshape(kvh, grp, 1, 1, 1)
    m = jnp.maximum(jnp.max(s, axis=-1, keepdims=True), sink)
    p = jnp.exp(s - m)
    p = p / (jnp.sum(p, axis=-1, keepdims=True) + jnp.exp(sink - m))
    o = jnp.einsum('bhgnqk,bnkhd->bnqhgd', p.astype(v.dtype), vw)
    return o.reshape(bsz, t, ATTN_WIDTH)


def short_gated_conv(b_gate, c_gate, xin, conv_w):
    h = c_gate * xin
    hp = jnp.pad(h, ((0, 0), (CONV_K - 1, 0), (0, 0)))
    t = h.shape[1]
    y = conv_w[0] * hp[:, 0:t] + conv_w[1] * hp[:, 1:t + 1] + conv_w[2] * hp[:, 2:t + 2]
    return b_gate * y


def setup_inputs(seed: int = 0) -> dict:
    key = jax.random.key(seed)
    ks = jax.random.split(key, 13)
    nrm = jax.random.normal
    f32 = jnp.float32
    return {
        "x": nrm(ks[0], (BATCH, SEQ, D_MODEL), f32),
        "w_in": nrm(ks[1], (DEPTH, D_MODEL, N_IN), f32) * D_MODEL ** -0.5,
        "w_proj_hgrn": nrm(ks[2], (DEPTH, HGRN_WIDTH, D_MODEL), f32) * (HGRN_WIDTH ** -0.5 * BETA),
        "w_proj_attn": nrm(ks[3], (DEPTH, ATTN_WIDTH, D_MODEL), f32) * (ATTN_WIDTH ** -0.5 * BETA),
        "w_proj_conv": nrm(ks[4], (DEPTH, CONV_WIDTH, D_MODEL), f32) * (CONV_WIDTH ** -0.5 * BETA),
        "w_out": nrm(ks[5], (DEPTH, D_MODEL, D_MODEL), f32) * (D_MODEL ** -0.5 * BETA),
        "lb_param": nrm(ks[6], (DEPTH, HGRN_WIDTH), f32) * 0.5,
        "hgrn_norm_g": 1.0 + 0.02 * nrm(ks[7], (DEPTH, HGRN_WIDTH), f32),
        "attn_sinks": nrm(ks[8], (DEPTH, ATTN_HEADS), f32),
        "conv_w": nrm(ks[9], (DEPTH, CONV_K, CONV_WIDTH), f32) * CONV_K ** -0.5,
        "rel_bias": nrm(ks[10], (N_BUCKETS, ATTN_HEADS), f32) * 0.1,
        "ln_g": 1.0 + 0.02 * nrm(ks[11], (DEPTH, D_MODEL), f32),
        "ln_b": 0.02 * nrm(ks[12], (DEPTH, D_MODEL), f32),
    }


def reference(x, w_in, w_proj_hgrn, w_proj_attn, w_proj_conv, w_out, lb_param, hgrn_norm_g,
              attn_sinks, conv_w, rel_bias, ln_g, ln_b):
    bsz, t, _ = x.shape
    split_idx = [int(s) for s in np.cumsum(SPLIT_SIZES)[:-1]]
    lb_soft = jax.nn.softmax(lb_param.astype(jnp.float32), axis=0)
    lower_bounds = jnp.cumsum(lb_soft, axis=0) - lb_soft[0:1]
    bias = band_relative_bias(rel_bias)
    for l in range(DEPTH):
        u = x @ w_in[l]
        (a_q, a_f, a_i, a_g, b_q, b_k, b_v, b_g,
         c_b, c_c, c_x, c_g, m_a, m_b, m_c) = jnp.split(u, split_idx, axis=-1)
        o_a = hgrn2_mixer(a_q, a_f, a_i, lower_bounds[l])
        o_a = o_a * lax.rsqrt(jnp.mean(jnp.square(o_a), axis=-1, keepdims=True) + RMS_EPS)
        o_a = o_a.reshape(bsz, t, HGRN_WIDTH) * hgrn_norm_g[l].astype(jnp.float32)
        y_a = (o_a.astype(x.dtype) * jax.nn.silu(a_g)) @ w_proj_hgrn[l]
        o_b = swa_sink_attention(b_q, b_k, b_v, bias, attn_sinks[l])
        y_b = (o_b * jax.nn.silu(b_g)) @ w_proj_attn[l]
        o_c = short_gated_conv(c_b, c_c, c_x, conv_w[l])
        y_c = (o_c * jax.nn.silu(c_g)) @ w_proj_conv[l]
        merged = jax.nn.sigmoid(m_a) * y_a + jax.nn.sigmoid(m_b) * y_b + jax.nn.sigmoid(m_c) * y_c
        y = merged @ w_out[l]
        x = layer_norm(ALPHA * x + y, ln_g[l], ln_b[l])
    return x
```

```cpp
#include <hip/hip_runtime.h>
#include <hip/hip_cooperative_groups.h>
#include <cstdio>
namespace cg = cooperative_groups;
__device__ __forceinline__ int otid() { int t = threadIdx.x; asm volatile("" : "+v"(t)); return t; }
namespace pg8 {
#define PG8_LAS __attribute__((address_space(3)))
typedef unsigned short bf16_t;
typedef short bf16x8 __attribute__((ext_vector_type(8)));
typedef float f32x4 __attribute__((ext_vector_type(4)));
typedef unsigned u32x4 __attribute__((ext_vector_type(4)));
constexpr int BM = 256, BK = 64, HALF = 128, HTB = HALF * BK * 2  , STAGE_BYTES = 8 * HTB, NXCD = 8, WGM = 8;

__host__ __device__ __forceinline__ int lds_byte(int r, int c) { const int st = (r >> 4) * 2 + (c >> 5), rr = r & 15, cc = c & 31, ob = rr * 64 + cc * 2; return st * 1024 + (ob ^ (((ob >> 9) & 1) << 5)); }
__host__ __device__ __forceinline__ void stage_rc(int b, int& R, int& C) { const int st = b / 1024, sb = b % 1024, swz = sb ^ (((sb >> 9) & 1) << 5); R = (st >> 1) * 16 + swz / 64; C = (st & 1) * 32 + (swz % 64) / 2; }
__host__ __device__ __forceinline__ int perm32(int rho) { const int n = rho >> 4, i = rho & 15; return 8 * (i >> 2) + 4 * n + (i & 3); }

struct Unit { int pm, pn; };
struct Gemm { const bf16_t* A; const bf16_t* Bt; int M, N, K; };

struct StaticOrder {
    int nM, nN, nwg, G, c;
    __host__ __device__ void init(int M, int N, int G_, int c_) { nM = M / BM; nN = N / BM; nwg = nM * nN; G = G_; c = c_; }
    __host__ __device__ bool next(int i, Unit& u) const {
        const long L = (long)i * G + c; if (L >= nwg) return false;
        int wgid = (int)L; { const int q = nwg / NXCD, r = nwg % NXCD, xcd = wgid % NXCD, off = wgid / NXCD; wgid = (xcd < r ? xcd * (q + 1) : r * (q + 1) + (xcd - r) * q) + off; }
        const int nig = WGM * nN, gid = wgid / nig, fm = gid * WGM, gsz = (nM - fm) < WGM ? (nM - fm) : WGM;
        u.pm = fm + ((wgid % nig) % gsz); u.pn = (wgid % nig) / gsz; return true;
    }
    __device__ __forceinline__ void a_ready(const Unit&) const {}
    __device__ __forceinline__ void done(const Unit&) const {}
};

template <class Epi, class Sched, bool STAMP = false>
__device__ __forceinline__ void gemm_phase(PG8_LAS unsigned char* lds, const Gemm g, const Sched& S, const Epi& E, unsigned long long* stamps) {
    const int tid = otid(), wid = __builtin_amdgcn_readfirstlane(tid >> 6), lane = tid & 63, wr = wid >> 2, wc = wid & 3, fr = lane & 15, fq = lane >> 4;
    const int K = g.K, nt = K / BK;
    int ts_lo = 0, ts_hi = 0, nts = 0; const unsigned long long rt_entry = STAMP ? (unsigned long long)wall_clock64() : 0ull;
#define PG8_STAMP() do { if (STAMP && wid == 0 && nts < 64) { const unsigned long long _c = (unsigned long long)clock64(); \
        ts_lo = (lane == nts) ? (int)(unsigned)_c : ts_lo; ts_hi = (lane == nts) ? (int)(unsigned)(_c >> 32) : ts_hi; ++nts; } } while (0)
    PG8_STAMP();
    unsigned voffA[2], voffB[2];
#pragma unroll
    for (int i = 0; i < 2; ++i) { int R, C; stage_rc(tid * 16 + i * 8192, R, C); const int Rb = Epi::PERM ? ((R & ~31) + perm32(R & 31)) : R;
        voffA[i] = (unsigned)(R * K + C) * 2u; voffB[i] = (unsigned)(Rb * K + C) * 2u; }
    const size_t kstep = (size_t)(BK * 2);
    const size_t hstep = (size_t)HALF * K * 2;
    const size_t tstep = 2 * hstep;
    const unsigned ldsw = (unsigned)wid * 1024u;
    const int aoff = lds_byte(wr * 64 + fr, fq * 8), boff = lds_byte(wc * 32 + fr, fq * 8);
#define PG8_SA(b, h) (((b) * 2 + (h)) * HTB)
#define PG8_SB(b, h) ((4 + (b) * 2 + (h)) * HTB)
#define PG8_STAGE(bufoff, gbase, voff) do { _Pragma("unroll") for (int _i = 0; _i < 2; ++_i) \
        __builtin_amdgcn_global_load_lds((const unsigned*)((const char*)(gbase) + (voff)[_i]), (PG8_LAS unsigned*)(lds + (bufoff) + ldsw + _i * 8192), 16, 0, 0); } while (0)
#define PG8_LDA(dst, b, h) do { _Pragma("unroll") for (int m = 0; m < 4; ++m) _Pragma("unroll") for (int k = 0; k < 2; ++k) dst[m][k] = *(const PG8_LAS bf16x8*)(lds + PG8_SA(b, h) + aoff + m * 2048 + k * 1024); } while (0)
#define PG8_LDB(dst, b, h) do { _Pragma("unroll") for (int n = 0; n < 2; ++n) _Pragma("unroll") for (int k = 0; k < 2; ++k) dst[n][k] = *(const PG8_LAS bf16x8*)(lds + PG8_SB(b, h) + boff + n * 2048 + k * 1024); } while (0)
#define PG8_MMA(ai, bj, At, Bt) do { __builtin_amdgcn_s_setprio(1); _Pragma("unroll") for (int m = 0; m < 4; ++m) _Pragma("unroll") for (int n = 0; n < 2; ++n) _Pragma("unroll") for (int k = 0; k < 2; ++k) \
        acc[ai][bj][m][n] = __builtin_amdgcn_mfma_f32_16x16x32_bf16(Bt[n][k], At[m][k], acc[ai][bj][m][n], 0, 0, 0); __builtin_amdgcn_s_setprio(0); } while (0)
#define PG8_WAIT_V(n) asm volatile("s_waitcnt vmcnt(" #n ")" ::: "memory")
#define PG8_WAIT_L(n) asm volatile("s_waitcnt lgkmcnt(" #n ")" ::: "memory")
#define PG8_BAR __builtin_amdgcn_s_barrier()
#define PG8_SCHED __builtin_amdgcn_sched_barrier(0)
    Unit cur, nxt; int ui = 0;
    if (!S.next(0, cur)) return;
    f32x4 acc[2][2][4][2];
#pragma unroll
    for (int a = 0; a < 2; ++a)
#pragma unroll
        for (int b = 0; b < 2; ++b)
#pragma unroll
            for (int m = 0; m < 4; ++m)
#pragma unroll
                for (int n = 0; n < 2; ++n) acc[a][b][m][n] = (f32x4){0.f, 0.f, 0.f, 0.f};
    bf16x8 At[4][2], B0[2][2], B1[2][2];
    const char* cA = (const char*)g.A + (size_t)cur.pm * tstep; const char* cB = (const char*)g.Bt + (size_t)cur.pn * tstep;
    S.a_ready(cur);
    PG8_STAGE(PG8_SB(0, 0), cB, voffB); PG8_STAGE(PG8_SA(0, 0), cA, voffA); PG8_STAGE(PG8_SB(0, 1), cB + hstep, voffB); PG8_STAGE(PG8_SA(0, 1), cA + hstep, voffA);
    if (wr == 1) PG8_BAR;
    PG8_WAIT_V(4); PG8_BAR;
    PG8_STAGE(PG8_SB(1, 0), cB + kstep, voffB); PG8_STAGE(PG8_SA(1, 0), cA + kstep, voffA); PG8_STAGE(PG8_SB(1, 1), cB + hstep + kstep, voffB);
    PG8_WAIT_V(6); PG8_BAR;
    PG8_STAMP();
    for (;;) {
        const bool has_next = S.next(ui + 1, nxt);
        const char* nA = has_next ? (const char*)g.A + (size_t)nxt.pm * tstep : cA; const char* nB = has_next ? (const char*)g.Bt + (size_t)nxt.pn * tstep : cB;
        for (int t = 0; t < nt; t += 2) {
            const bool last = (t == nt - 2);
            const char* a1 = cA + (size_t)(t + 1) * kstep;
            const char* a2 = last ? nA : cA + (size_t)(t + 2) * kstep; const char* b2 = last ? nB : cB + (size_t)(t + 2) * kstep;
            const char* a3 = a2 + kstep; const char* b3 = b2 + kstep;
            if (last && has_next) S.a_ready(nxt);
            PG8_LDB(B0, 0, 0); PG8_SCHED; PG8_LDA(At, 0, 0); PG8_STAGE(PG8_SA(1, 1), a1 + hstep, voffA);
            PG8_WAIT_L(8); PG8_BAR; PG8_WAIT_L(0); PG8_MMA(0, 0, At, B0); PG8_BAR; PG8_SCHED;
            PG8_LDB(B1, 0, 1); PG8_STAGE(PG8_SB(0, 0), b2, voffB);
            PG8_BAR; PG8_WAIT_L(0); PG8_MMA(0, 1, At, B1); PG8_BAR;
            PG8_LDA(At, 0, 1); PG8_STAGE(PG8_SA(0, 0), a2, voffA);
            PG8_BAR; PG8_WAIT_L(0); PG8_MMA(1, 0, At, B0); PG8_BAR; PG8_SCHED;
            PG8_STAGE(PG8_SB(0, 1), b2 + hstep, voffB);
            PG8_WAIT_V(6); PG8_BAR; PG8_MMA(1, 1, At, B1); PG8_BAR;
            PG8_LDB(B0, 1, 0); PG8_SCHED; PG8_LDA(At, 1, 0); PG8_STAGE(PG8_SA(0, 1), a2 + hstep, voffA);
            PG8_WAIT_L(8); PG8_BAR; PG8_WAIT_L(0); PG8_MMA(0, 0, At, B0); PG8_BAR; PG8_SCHED;
            PG8_LDB(B1, 1, 1); PG8_STAGE(PG8_SB(1, 0), b3, voffB);
            PG8_BAR; PG8_WAIT_L(0); PG8_MMA(0, 1, At, B1); PG8_BAR;
            PG8_LDA(At, 1, 1); PG8_STAGE(PG8_SA(1, 0), a3, voffA);
            PG8_BAR; PG8_WAIT_L(0); PG8_MMA(1, 0, At, B0); PG8_BAR; PG8_SCHED;
            PG8_STAGE(PG8_SB(1, 1), b3 + hstep, voffB);
            PG8_WAIT_V(6); PG8_BAR; PG8_MMA(1, 1, At, B1); PG8_BAR;
        }
        PG8_STAMP();
        if constexpr (!Epi::AFTER_DRAIN) { E(acc, cur, wr, wc, fr, fq); S.done(cur); }
        PG8_STAMP();
        if (!has_next) break;
#pragma unroll
        for (int a = 0; a < 2; ++a)
#pragma unroll
            for (int b = 0; b < 2; ++b)
#pragma unroll
                for (int m = 0; m < 4; ++m)
#pragma unroll
                    for (int n = 0; n < 2; ++n) acc[a][b][m][n] = (f32x4){0.f, 0.f, 0.f, 0.f};
        cur = nxt; cA = nA; cB = nB; ++ui;
    }
    PG8_WAIT_V(0);
    if (wr == 0) PG8_BAR;
    PG8_BAR;
    if constexpr (Epi::AFTER_DRAIN) { E.fused(acc, cur, wr, wc, fr, fq, lds, wid, lane); S.done(cur); }
    PG8_STAMP();
    if (STAMP && wid == 0) { stamps[lane] = lane < nts ? (((unsigned long long)(unsigned)ts_hi << 32) | (unsigned)ts_lo) : 0ull;
        if (lane == 62) stamps[62] = rt_entry; if (lane == 63) stamps[63] = (unsigned long long)wall_clock64(); }
#undef PG8_STAMP
#undef PG8_SA
#undef PG8_SB
#undef PG8_STAGE
#undef PG8_LDA
#undef PG8_LDB
#undef PG8_MMA
#undef PG8_WAIT_V
#undef PG8_WAIT_L
#undef PG8_BAR
#undef PG8_SCHED
}
}

#define LAS __attribute__((address_space(3)))
#define DI __device__ __forceinline__
using pg8::bf16_t; using pg8::bf16x8; using pg8::f32x4; using pg8::u32x4;
typedef float f32x2 __attribute__((ext_vector_type(2)));
typedef unsigned u32x2 __attribute__((ext_vector_type(2)));
typedef short s16x4 __attribute__((ext_vector_type(4)));
typedef __bf16 bf2_t __attribute__((ext_vector_type(2)));

constexpr int D_ = 2048, SEQ_ = 8192, M_ = 16384, DEPTH_ = 4, NIN_ = 16896;
constexpr int UC_AQ = 0, UC_AF = 1024, UC_AI = 2048, UC_AG = 3072, UC_BQ = 4096, UC_BK = 5120, UC_BV = 5376, UC_BG = 5632,
              UC_CB = 6656, UC_CC = 7680, UC_CX = 8704, UC_CG = 9728, UC_MA = 10752;
constexpr float ALPHA_ = 1.681792830507429f;
constexpr int LDS_BYTES = 147456;

constexpr size_t SZ_WIN = (size_t)DEPTH_ * NIN_ * D_ * 2, SZ_WP = (size_t)DEPTH_ * 2048 * 1024 * 2, SZ_WOUT = (size_t)DEPTH_ * 2048 * 2048 * 2;
constexpr size_t WS_WIN = 0, WS_WPA = WS_WIN + SZ_WIN, WS_WPB = WS_WPA + SZ_WP, WS_WPC = WS_WPB + SZ_WP, WS_WOUT = WS_WPC + SZ_WP;
constexpr size_t WS_U = WS_WOUT + SZ_WOUT, WS_X = WS_U + (size_t)M_ * NIN_ * 2, WS_XB = WS_X + (size_t)M_ * D_ * 4, WS_GA = WS_XB + (size_t)M_ * D_ * 2;
constexpr size_t WS_GB = WS_GA + (size_t)M_ * 1024 * 2, WS_GC = WS_GB + (size_t)M_ * 1024 * 2, WS_MG = WS_GC + (size_t)M_ * 1024 * 2;
constexpr size_t WS_DS = WS_MG + (size_t)M_ * D_ * 2, WS_SIN = WS_DS + (size_t)2048 * 16384 * 4, WS_DEC = WS_SIN + (size_t)2048 * 16384 * 2;
constexpr size_t WS_LB = WS_DEC + (size_t)2048 * 128 * 4, WS_BIAS = WS_LB + 4 * 1024 * 4, WS_END = WS_BIAS + 16 * 128 * 4;

struct Params {
    const float* x; const float* w_in; const float* w_pa; const float* w_pb; const float* w_pc; const float* w_out; const float* lb_param;
    const float* norm_g; const float* sinks; const float* conv_w; const float* rel_bias; const float* ln_g; const float* ln_b;
    float* out; unsigned char* ws;
};

DI float bf_lo(unsigned u) { return __uint_as_float(u << 16); }
DI float bf_hi(unsigned u) { return __uint_as_float(u & 0xffff0000u); }
DI float bf1(bf16_t h) { return __uint_as_float(((unsigned)h) << 16); }
DI unsigned pk2(float lo, float hi) { f32x2 v = {lo, hi}; return __builtin_bit_cast(unsigned, __builtin_convertvector(v, bf2_t)); }
DI bf16_t f2bf(float x) { return (bf16_t)(pk2(x, 0.f) & 0xffffu); }
DI float fsigmoid(float x) { return __builtin_amdgcn_rcpf(1.0f + __expf(-x)); }
DI void unpack8(const u32x4 v, float (&o)[8]) {
    o[0] = bf_lo(v[0]); o[1] = bf_hi(v[0]); o[2] = bf_lo(v[1]); o[3] = bf_hi(v[1]); o[4] = bf_lo(v[2]); o[5] = bf_hi(v[2]); o[6] = bf_lo(v[3]); o[7] = bf_hi(v[3]);
}
DI f32x4 mfma16(bf16x8 a, bf16x8 b, f32x4 c) { return __builtin_amdgcn_mfma_f32_16x16x32_bf16(a, b, c, 0, 0, 0); }

struct EpiIn {
    static constexpr bool PERM = true, AFTER_DRAIN = false;
    bf16_t* U; const float* lb;
    template <int MODE> DI void run(const f32x4 (&acc)[2][2][4][2], const pg8::Unit& u, int wr, int wc, int fr, int fq, float scale) const {
        const int row0 = u.pm * 256 + wr * 64 + fr, col0 = u.pn * 256 + wc * 32 + 8 * fq;
        f32x4 l0[2], l1[2];
#pragma unroll
        for (int bj = 0; bj < 2; ++bj) {
            if (MODE == 3) { l0[bj] = *(const f32x4*)(lb + (col0 - UC_AF) + bj * 128); l1[bj] = *(const f32x4*)(lb + (col0 - UC_AF) + bj * 128 + 4); }
            else { l0[bj] = (f32x4){0.f, 0.f, 0.f, 0.f}; l1[bj] = l0[bj]; }
        }
#pragma unroll
        for (int ai = 0; ai < 2; ++ai)
#pragma unroll
            for (int m = 0; m < 4; ++m) {
                bf16_t* rowp = U + (size_t)(row0 + ai * 128 + m * 16) * NIN_ + col0;
#pragma unroll
                for (int bj = 0; bj < 2; ++bj) {
                    float o[8];
#pragma unroll
                    for (int e = 0; e < 8; ++e) {
                        const float v = (e < 4) ? acc[ai][bj][m][0][e & 3] : acc[ai][bj][m][1][e & 3];
                        const float lbv = (e < 4) ? l0[bj][e & 3] : l1[bj][e & 3];
                        float r;
                        if (MODE == 0) r = v * scale;
                        else if (MODE == 1) r = v * fsigmoid(v) * scale;
                        else if (MODE == 2) r = fsigmoid(v);
                        else r = __logf(lbv + (1.0f - lbv) * fsigmoid(v));
                        o[e] = r;
                    }
                    u32x4 pk = {pk2(o[0], o[1]), pk2(o[2], o[3]), pk2(o[4], o[5]), pk2(o[6], o[7])};
                    *(u32x4*)(rowp + bj * 128) = pk;
                }
            }
    }
    DI void operator()(const f32x4 (&acc)[2][2][4][2], const pg8::Unit& u, int wr, int wc, int fr, int fq) const {
        const int pn = u.pn;
        if (pn < 4) run<1>(acc, u, wr, wc, fr, fq, 0.08838834764831845f);
        else if (pn < 8) run<3>(acc, u, wr, wc, fr, fq, 1.f);
        else if (pn < 12) run<0>(acc, u, wr, wc, fr, fq, 1.f);
        else if (pn < 16) run<1>(acc, u, wr, wc, fr, fq, 1.f);
        else if (pn < 20) run<0>(acc, u, wr, wc, fr, fq, 0.125f);
        else if (pn < 22) run<0>(acc, u, wr, wc, fr, fq, 1.f);
        else if (pn < 26) run<1>(acc, u, wr, wc, fr, fq, 1.f);
        else if (pn < 38) run<0>(acc, u, wr, wc, fr, fq, 1.f);
        else if (pn < 42) run<1>(acc, u, wr, wc, fr, fq, 1.f);
        else run<2>(acc, u, wr, wc, fr, fq, 1.f);
    }
};
struct EpiMerge {
    static constexpr bool PERM = true, AFTER_DRAIN = false;
    const bf16_t* gate; bf16_t* Mg; int first;
    DI void operator()(const f32x4 (&acc)[2][2][4][2], const pg8::Unit& u, int wr, int wc, int fr, int fq) const {
        const int row0 = u.pm * 256 + wr * 64 + fr, col0 = u.pn * 256 + wc * 32 + 8 * fq;
#pragma unroll
        for (int ai = 0; ai < 2; ++ai)
#pragma unroll
            for (int m = 0; m < 4; ++m) {
                const size_t r = (size_t)(row0 + ai * 128 + m * 16);
                const bf16_t* gp = gate + r * NIN_ + col0; bf16_t* mp = Mg + r * D_ + col0;
#pragma unroll
                for (int bj = 0; bj < 2; ++bj) {
                    const u32x4 gv = *(const u32x4*)(gp + bj * 128);
                    u32x4 pv = {0u, 0u, 0u, 0u};
                    if (!first) pv = *(const u32x4*)(mp + bj * 128);
                    float g[8], p[8], o[8];
                    unpack8(gv, g); unpack8(pv, p);
#pragma unroll
                    for (int e = 0; e < 8; ++e) { const float a = (e < 4) ? acc[ai][bj][m][0][e & 3] : acc[ai][bj][m][1][e & 3]; o[e] = p[e] + g[e] * a; }
                    u32x4 pk = {pk2(o[0], o[1]), pk2(o[2], o[3]), pk2(o[4], o[5]), pk2(o[6], o[7])};
                    *(u32x4*)(mp + bj * 128) = pk;
                }
            }
    }
};
struct EpiOut {
    static constexpr bool PERM = false, AFTER_DRAIN = false;
    float* X;
    DI void operator()(const f32x4 (&acc)[2][2][4][2], const pg8::Unit& u, int wr, int wc, int fr, int fq) const {
        const int row0 = u.pm * 256 + wr * 64 + fr, col0 = u.pn * 256 + wc * 32 + 4 * fq;
#pragma unroll
        for (int ai = 0; ai < 2; ++ai)
#pragma unroll
            for (int m = 0; m < 4; ++m) {
                float* rowp = X + (size_t)(row0 + ai * 128 + m * 16) * D_ + col0;
#pragma unroll
                for (int bj = 0; bj < 2; ++bj)
#pragma unroll
                    for (int n = 0; n < 2; ++n) { f32x4* p = (f32x4*)(rowp + bj * 128 + n * 16); *p = *p * ALPHA_ + acc[ai][bj][m][n]; }
            }
    }
};

DI void transpose_convert(LAS unsigned char* lds, const float* W, bf16_t* Wt, int K, int N, int wg, int nwg) {
    LAS float* T = (LAS float*)lds;
    const int tid = otid(), tn = N / 64, nt = tn * (K / 64);
    for (int t = wg; t < nt; t += nwg) {
        const int k0 = (t / tn) * 64, n0 = (t % tn) * 64;
#pragma unroll
        for (int e = 0; e < 2; ++e) {
            const int idx = tid + 512 * e, kk = idx >> 4, n4 = (idx & 15) * 4;
            const f32x4 v = *(const f32x4*)(W + (size_t)(k0 + kk) * N + n0 + n4);
            T[kk * 65 + n4 + 0] = v[0]; T[kk * 65 + n4 + 1] = v[1]; T[kk * 65 + n4 + 2] = v[2]; T[kk * 65 + n4 + 3] = v[3];
        }
        __syncthreads();
        {
            const int n = tid >> 3, kg = tid & 7;
            float o[8];
#pragma unroll
            for (int j = 0; j < 8; ++j) o[j] = T[(kg * 8 + j) * 65 + n];
            u32x4 pk = {pk2(o[0], o[1]), pk2(o[2], o[3]), pk2(o[4], o[5]), pk2(o[6], o[7])};
            *(u32x4*)(Wt + (size_t)(n0 + n) * K + k0 + kg * 8) = pk;
        }
        __syncthreads();
    }
}

DI float wave_sum(float v) {
#pragma unroll
    for (int o = 32; o >= 1; o >>= 1) v += __shfl_xor(v, o);
    return v;
}

DI void ln_phase(const float* X, float* dst, bf16_t* XB, const float* g, const float* b, int wg, int nwg) {
    const int tid = otid(), lane = tid & 63, wave = tid >> 6;
    for (int row = wg * 8 + wave; row < M_; row += nwg * 8) {
        const float* xr = X + (size_t)row * D_;
        f32x4 v[8];
#pragma unroll
        for (int e = 0; e < 8; ++e) v[e] = *(const f32x4*)(xr + e * 256 + lane * 4);
        float s = 0.f;
#pragma unroll
        for (int e = 0; e < 8; ++e) s += (v[e][0] + v[e][1]) + (v[e][2] + v[e][3]);
        const float mu = wave_sum(s) * (1.0f / 2048.0f);
        float ss = 0.f;
#pragma unroll
        for (int e = 0; e < 8; ++e) { v[e] = v[e] - mu; ss += (v[e][0] * v[e][0] + v[e][1] * v[e][1]) + (v[e][2] * v[e][2] + v[e][3] * v[e][3]); }
        const float rstd = rsqrtf(wave_sum(ss) * (1.0f / 2048.0f) + 1e-5f);
#pragma unroll
        for (int e = 0; e < 8; ++e) {
            const int c = e * 256 + lane * 4;
            const f32x4 gg = *(const f32x4*)(g + c), bb = *(const f32x4*)(b + c);
            const f32x4 y = v[e] * rstd * gg + bb;
            *(f32x4*)(dst + (size_t)row * D_ + c) = y;
            u32x2 pk = {pk2(y[0], y[1]), pk2(y[2], y[3])};
            *(u32x2*)(XB + (size_t)row * D_ + c) = pk;
        }
    }
}

DI void conv_phase(const bf16_t* U, bf16_t* GC, const float* cw, int wg, int nwg) {
    for (int task = wg * 512 + otid(); task < 131072; task += nwg * 512) {
        const int ch0 = (task & 127) * 8, tok0 = (task >> 7) * 16;
        float w0[8], w1[8], w2[8], h1[8], h2[8];
#pragma unroll
        for (int e = 0; e < 8; ++e) { w0[e] = cw[ch0 + e]; w1[e] = cw[1024 + ch0 + e]; w2[e] = cw[2048 + ch0 + e]; h1[e] = 0.f; h2[e] = 0.f; }
        if ((tok0 & (SEQ_ - 1)) != 0) {
            float a[8], c[8];
            unpack8(*(const u32x4*)(U + (size_t)(tok0 - 1) * NIN_ + UC_CC + ch0), a); unpack8(*(const u32x4*)(U + (size_t)(tok0 - 1) * NIN_ + UC_CX + ch0), c);
#pragma unroll
            for (int e = 0; e < 8; ++e) h1[e] = a[e] * c[e];
            unpack8(*(const u32x4*)(U + (size_t)(tok0 - 2) * NIN_ + UC_CC + ch0), a); unpack8(*(const u32x4*)(U + (size_t)(tok0 - 2) * NIN_ + UC_CX + ch0), c);
#pragma unroll
            for (int e = 0; e < 8; ++e) h2[e] = a[e] * c[e];
        }
#pragma unroll 2
        for (int i = 0; i < 16; ++i) {
            const bf16_t* up = U + (size_t)(tok0 + i) * NIN_ + ch0;
            float cc[8], cx[8], cb[8], cgt[8], o[8];
            unpack8(*(const u32x4*)(up + UC_CC), cc); unpack8(*(const u32x4*)(up + UC_CX), cx); unpack8(*(const u32x4*)(up + UC_CB), cb); unpack8(*(const u32x4*)(up + UC_CG), cgt);
#pragma unroll
            for (int e = 0; e < 8; ++e) {
                const float h0 = cc[e] * cx[e];
                const float y = w0[e] * h2[e] + w1[e] * h1[e] + w2[e] * h0;
                o[e] = cb[e] * y * cgt[e];
                h2[e] = h1[e]; h1[e] = h0;
            }
            u32x4 pk = {pk2(o[0], o[1]), pk2(o[2], o[3]), pk2(o[4], o[5]), pk2(o[6], o[7])};
            *(u32x4*)(GC + (size_t)(tok0 + i) * 1024 + ch0) = pk;
        }
    }
}

constexpr int HL_G = 0, HL_B = 32768, HL_TOT = 65536, HL_RED = 67584;
constexpr int H1_VT = 68096, H1_KET = H1_VT + 128 * 72 * 2;
constexpr int H3_QE = 68096, H3_QM = H3_QE + 64 * 136 * 2, H3_KM = H3_QM + 64 * 136 * 2, H3_VT = H3_KM + 64 * 136 * 2;
static_assert(H3_VT + 128 * 72 * 2 <= LDS_BYTES, "LDS");

DI void hgrn_stage(LAS unsigned char* lds, int vt_off, const bf16_t* U, int row0, int h) {
    LAS float* gL = (LAS float*)(lds + HL_G); LAS float* bL = (LAS float*)(lds + HL_B); LAS float* tot = (LAS float*)(lds + HL_TOT);
    LAS bf16_t* vT = (LAS bf16_t*)(lds + vt_off);
    const int tid = otid();
#pragma unroll
    for (int e = 0; e < 2; ++e) {
        const int id = tid + 512 * e, t = id >> 4, c8 = (id & 15) * 8;
        const bf16_t* up = U + (size_t)(row0 + t) * NIN_ + h * 128 + c8;
        const u32x4 gv = *(const u32x4*)(up + UC_AF), vv = *(const u32x4*)(up + UC_AI);
        float gf[8]; unpack8(gv, gf);
        *(LAS f32x4*)(gL + t * 128 + c8) = (f32x4){gf[0], gf[1], gf[2], gf[3]};
        *(LAS f32x4*)(gL + t * 128 + c8 + 4) = (f32x4){gf[4], gf[5], gf[6], gf[7]};
#pragma unroll
        for (int j = 0; j < 4; ++j) { vT[(c8 + 2 * j) * 72 + t] = (bf16_t)(vv[j] & 0xffffu); vT[(c8 + 2 * j + 1) * 72 + t] = (bf16_t)(vv[j] >> 16); }
    }
    __syncthreads();
    {
        const int k = tid & 127, part = tid >> 7;
        float run = 0.f;
#pragma unroll
        for (int i = 0; i < 16; ++i) { const int t = part * 16 + i; run += gL[t * 128 + k]; bL[t * 128 + k] = run; }
        tot[part * 128 + k] = run;
    }
    __syncthreads();
}

DI void hgrn_local_phase(LAS unsigned char* lds, const bf16_t* U, float* DS, float* DEC, int wg, int nwg) {
    LAS float* gL = (LAS float*)(lds + HL_G); LAS float* bL = (LAS float*)(lds + HL_B); LAS float* tot = (LAS float*)(lds + HL_TOT);
    LAS bf16_t* vT = (LAS bf16_t*)(lds + H1_VT); LAS bf16_t* keT = (LAS bf16_t*)(lds + H1_KET);
    const int tid = otid(), lane = tid & 63, w = tid >> 6, fr = lane & 15, fq = lane >> 4;
    for (int it = wg; it < 2048; it += nwg) {
        const int c = it & 127, bh = it >> 7, b = bh >> 3, h = bh & 7, row0 = b * SEQ_ + c * 64;
        hgrn_stage(lds, H1_VT, U, row0, h);
        {
            const int k = tid & 127, sg = tid >> 7;
            const float t0 = tot[k], t1 = tot[128 + k], t2 = tot[256 + k], t3 = tot[384 + k];
            const float bend = (t0 + t1) + (t2 + t3);
            const float pre = sg == 0 ? 0.f : (sg == 1 ? t0 : (sg == 2 ? t0 + t1 : t0 + t1 + t2));
            unsigned pk[8];
#pragma unroll
            for (int i = 0; i < 16; i += 2) {
                const int s = sg * 16 + i;
                const float ke0 = (1.0f - __expf(gL[s * 128 + k])) * __expf(bend - (bL[s * 128 + k] + pre));
                const float ke1 = (1.0f - __expf(gL[(s + 1) * 128 + k])) * __expf(bend - (bL[(s + 1) * 128 + k] + pre));
                pk[i >> 1] = pk2(ke0, ke1);
            }
            *(LAS u32x4*)(keT + k * 72 + sg * 16) = (u32x4){pk[0], pk[1], pk[2], pk[3]};
            *(LAS u32x4*)(keT + k * 72 + sg * 16 + 8) = (u32x4){pk[4], pk[5], pk[6], pk[7]};
            if (sg == 0) DEC[(size_t)it * 128 + k] = __expf(bend);
        }
        __syncthreads();
        {
            bf16x8 a[2];
#pragma unroll
            for (int ks = 0; ks < 2; ++ks) a[ks] = *(const LAS bf16x8*)(keT + (16 * w + fr) * 72 + ks * 32 + 8 * fq);
#pragma unroll
            for (int vt = 0; vt < 8; ++vt) {
                f32x4 acc = {0.f, 0.f, 0.f, 0.f};
#pragma unroll
                for (int ks = 0; ks < 2; ++ks) { const bf16x8 bb = *(const LAS bf16x8*)(vT + (16 * vt + fr) * 72 + ks * 32 + 8 * fq); acc = mfma16(a[ks], bb, acc); }
                *(f32x4*)(DS + (size_t)it * 16384 + (16 * vt + fr) * 128 + 16 * w + 4 * fq) = acc;
            }
        }
        __syncthreads();
    }
}

DI void hgrn_scan_phase(const float* DS, const float* DEC, bf16_t* SIN, int wg, int nwg) {
    for (int gt = wg * 512 + otid(); gt < 131072; gt += nwg * 512) {
        const int bh = gt >> 13, rem = gt & 8191, v = rem >> 6, k2 = (rem & 63) * 2;
        f32x2 st = {0.f, 0.f};
        const size_t base = (size_t)bh * 128;
#pragma unroll 8
        for (int c = 0; c < 128; ++c) {
            const size_t idx = base + c;
            const f32x2 d2 = *(const f32x2*)(DEC + idx * 128 + k2);
            const f32x2 dl = *(const f32x2*)(DS + idx * 16384 + v * 128 + k2);
            *(unsigned*)(SIN + idx * 16384 + v * 128 + k2) = pk2(st[0], st[1]);
            st = d2 * st + dl;
        }
    }
}

DI void hgrn_out_phase(LAS unsigned char* lds, const bf16_t* U, const bf16_t* SIN, bf16_t* GA, const float* ng, int wg, int nwg) {
    LAS float* gL = (LAS float*)(lds + HL_G); LAS float* bL = (LAS float*)(lds + HL_B); LAS float* tot = (LAS float*)(lds + HL_TOT); LAS float* red = (LAS float*)(lds + HL_RED);
    LAS bf16_t* qeL = (LAS bf16_t*)(lds + H3_QE); LAS bf16_t* qmL = (LAS bf16_t*)(lds + H3_QM); LAS bf16_t* kmL = (LAS bf16_t*)(lds + H3_KM); LAS bf16_t* vT = (LAS bf16_t*)(lds + H3_VT);
    const int tid = otid(), lane = tid & 63, w = tid >> 6, fr = lane & 15, fq = lane >> 4;
    const int tt = w & 3, vh = w >> 2;
    for (int it = wg; it < 2048; it += nwg) {
        const int c = it & 127, bh = it >> 7, b = bh >> 3, h = bh & 7, row0 = b * SEQ_ + c * 64;
        hgrn_stage(lds, H3_VT, U, row0, h);
        {
            const int k = tid & 127, tg = tid >> 7;
            const float t0 = tot[k], t1 = tot[128 + k], t2 = tot[256 + k];
            const float pre = tg == 0 ? 0.f : (tg == 1 ? t0 : (tg == 2 ? t0 + t1 : t0 + t1 + t2));
            const float r = t0 + bL[31 * 128 + k];
#pragma unroll 4
            for (int i = 0; i < 16; ++i) {
                const int t = tg * 16 + i;
                const float bt = bL[t * 128 + k] + pre, gt = gL[t * 128 + k];
                const float qf = bf1(U[(size_t)(row0 + t) * NIN_ + UC_AQ + h * 128 + k]);
                qeL[t * 136 + k] = f2bf(qf * __expf(bt));
                qmL[t * 136 + k] = f2bf(qf * __expf(bt - r));
                kmL[t * 136 + k] = f2bf((1.0f - __expf(gt)) * __expf(r - bt));
            }
        }
        __syncthreads();
        f32x4 acc[4];
#pragma unroll
        for (int vi = 0; vi < 4; ++vi) acc[vi] = (f32x4){0.f, 0.f, 0.f, 0.f};
        {
            bf16x8 qmf[4];
#pragma unroll
            for (int ks = 0; ks < 4; ++ks) qmf[ks] = *(const LAS bf16x8*)(qmL + (16 * tt + fr) * 136 + ks * 32 + 8 * fq);
            f32x4 sc[4];
#pragma unroll
            for (int st = 0; st < 4; ++st) {
                sc[st] = (f32x4){0.f, 0.f, 0.f, 0.f};
                if (st <= tt) {
#pragma unroll
                    for (int ks = 0; ks < 4; ++ks) { const bf16x8 a = *(const LAS bf16x8*)(kmL + (16 * st + fr) * 136 + ks * 32 + 8 * fq); sc[st] = mfma16(a, qmf[ks], sc[st]); }
                    if (st == tt) {
#pragma unroll
                        for (int j = 0; j < 4; ++j) sc[st][j] = (4 * fq + j <= fr) ? sc[st][j] : 0.f;
                    }
                }
            }
#pragma unroll
            for (int p = 0; p < 2; ++p) {
                if (2 * p <= tt) {
                    const u32x4 pku = {pk2(sc[2 * p][0], sc[2 * p][1]), pk2(sc[2 * p][2], sc[2 * p][3]), pk2(sc[2 * p + 1][0], sc[2 * p + 1][1]), pk2(sc[2 * p + 1][2], sc[2 * p + 1][3])};
                    const bf16x8 P = __builtin_bit_cast(bf16x8, pku);
#pragma unroll
                    for (int vi = 0; vi < 4; ++vi) {
                        const int v = 16 * (vh * 4 + vi) + fr;
                        const u32x2 lo = *(const LAS u32x2*)(vT + v * 72 + 32 * p + 4 * fq), hi = *(const LAS u32x2*)(vT + v * 72 + 32 * p + 16 + 4 * fq);
                        const u32x4 au = {lo[0], lo[1], hi[0], hi[1]};
                        acc[vi] = mfma16(__builtin_bit_cast(bf16x8, au), P, acc[vi]);
                    }
                }
            }
#pragma unroll
            for (int ks = 0; ks < 4; ++ks) {
                const bf16x8 bq = *(const LAS bf16x8*)(qeL + (16 * tt + fr) * 136 + ks * 32 + 8 * fq);
#pragma unroll
                for (int vi = 0; vi < 4; ++vi) {
                    const int v = 16 * (vh * 4 + vi) + fr;
                    const bf16x8 a = *(const bf16x8*)(SIN + (size_t)it * 16384 + v * 128 + ks * 32 + 8 * fq);
                    acc[vi] = mfma16(a, bq, acc[vi]);
                }
            }
        }
        float ss = 0.f;
#pragma unroll
        for (int vi = 0; vi < 4; ++vi) ss += (acc[vi][0] * acc[vi][0] + acc[vi][1] * acc[vi][1]) + (acc[vi][2] * acc[vi][2] + acc[vi][3] * acc[vi][3]);
        ss += __shfl_xor(ss, 16); ss += __shfl_xor(ss, 32);
        if (fq == 0) red[vh * 64 + 16 * tt + fr] = ss;
        __syncthreads();
        {
            const float tot2 = red[16 * tt + fr] + red[64 + 16 * tt + fr];
            const float rinv = rsqrtf(tot2 * (1.0f / 128.0f) + 1e-6f);
            const size_t trow = (size_t)(row0 + 16 * tt + fr);
#pragma unroll
            for (int vi = 0; vi < 4; ++vi) {
                const int vb = h * 128 + 16 * (vh * 4 + vi) + 4 * fq;
                const f32x4 g4 = *(const f32x4*)(ng + vb);
                const u32x2 gate = *(const u32x2*)(U + trow * NIN_ + UC_AG + vb);
                const float o0 = acc[vi][0] * rinv * g4[0] * bf_lo(gate[0]), o1 = acc[vi][1] * rinv * g4[1] * bf_hi(gate[0]);
                const float o2 = acc[vi][2] * rinv * g4[2] * bf_lo(gate[1]), o3 = acc[vi][3] * rinv * g4[3] * bf_hi(gate[1]);
                u32x2 pk = {pk2(o0, o1), pk2(o2, o3)};
                *(u32x2*)(GA + trow * 1024 + vb) = pk;
            }
        }
        __syncthreads();
    }
}

constexpr int AT_K = 0, AT_VT = 256 * 72 * 2, AT_BIAS = AT_VT + 64 * 264 * 2;
DI void attn_phase(LAS unsigned char* lds, const bf16_t* U, bf16_t* GB, const float* BIAS, const float* sinks, int wg, int nwg) {
    LAS bf16_t* Kl = (LAS bf16_t*)(lds + AT_K); LAS bf16_t* Vt = (LAS bf16_t*)(lds + AT_VT); LAS float* biasL = (LAS float*)(lds + AT_BIAS);
    const int tid = otid(), lane = tid & 63, w = tid >> 6, fr = lane & 15, fq = lane >> 4;
    for (int it = wg; it < 512; it += nwg) {
        const int kvh = it & 3, blk = (it >> 2) & 63, b = it >> 8;
        const int rc0 = b * SEQ_ + blk * 128, rp0 = blk > 0 ? rc0 - 128 : rc0;
#pragma unroll
        for (int e = 0; e < 4; ++e) {
            const int id = tid + 512 * e, j = id >> 3, c8 = (id & 7) * 8;
            const int row = j < 128 ? rp0 + j : rc0 + j - 128;
            const bf16_t* up = U + (size_t)row * NIN_ + kvh * 64 + c8;
            const u32x4 kv = *(const u32x4*)(up + UC_BK), vv = *(const u32x4*)(up + UC_BV);
            *(LAS u32x4*)(Kl + j * 72 + c8) = kv;
#pragma unroll
            for (int q = 0; q < 4; ++q) { Vt[(c8 + 2 * q) * 264 + j] = (bf16_t)(vv[q] & 0xffffu); Vt[(c8 + 2 * q + 1) * 264 + j] = (bf16_t)(vv[q] >> 16); }
        }
        biasL[tid] = BIAS[(kvh * 4 + (tid >> 7)) * 128 + (tid & 127)];
        __syncthreads();
#pragma unroll 1
        for (int e = 0; e < 4; ++e) {
            const int unit = w * 4 + e, g = unit >> 3, mt = unit & 7, hq = kvh * 4 + g;
            const size_t qrow = (size_t)(rc0 + 16 * mt + fr);
            bf16x8 qf[2];
#pragma unroll
            for (int ks = 0; ks < 2; ++ks) qf[ks] = *(const bf16x8*)(U + qrow * NIN_ + UC_BQ + hq * 64 + ks * 32 + 8 * fq);
            f32x4 sc[9];
#pragma unroll
            for (int n = 0; n < 9; ++n) {
                sc[n] = (f32x4){0.f, 0.f, 0.f, 0.f};
#pragma unroll
                for (int ks = 0; ks < 2; ++ks) { const bf16x8 a = *(const LAS bf16x8*)(Kl + (16 * (mt + n) + fr) * 72 + ks * 32 + 8 * fq); sc[n] = mfma16(a, qf[ks], sc[n]); }
            }
            float mx = -INFINITY;
#pragma unroll
            for (int n = 0; n < 9; ++n)
#pragma unroll
                for (int j = 0; j < 4; ++j) {
                    const int rel = 128 + fr - 16 * n - 4 * fq - j, jidx = 16 * (mt + n) + 4 * fq + j;
                    const bool valid = (rel >= 0) && (rel <= 127) && (blk > 0 || jidx >= 128);
                    const int relc = rel < 0 ? 0 : (rel > 127 ? 127 : rel);
                    const float s = valid ? sc[n][j] + biasL[g * 128 + relc] : -INFINITY;
                    sc[n][j] = s; mx = fmaxf(mx, s);
                }
            mx = fmaxf(mx, __shfl_xor(mx, 16)); mx = fmaxf(mx, __shfl_xor(mx, 32));
            const float sink = sinks[hq];
            const float mm = fmaxf(mx, sink);
            float lsum = 0.f;
#pragma unroll
            for (int n = 0; n < 9; ++n)
#pragma unroll
                for (int j = 0; j < 4; ++j) { const float pz = __expf(sc[n][j] - mm); sc[n][j] = pz; lsum += pz; }
            lsum += __shfl_xor(lsum, 16); lsum += __shfl_xor(lsum, 32);
            lsum += __expf(sink - mm);
            const float inv = 1.0f / lsum;
            f32x4 o[4];
#pragma unroll
            for (int dt = 0; dt < 4; ++dt) o[dt] = (f32x4){0.f, 0.f, 0.f, 0.f};
#pragma unroll
            for (int q = 0; q < 5; ++q) {
                const int na = 2 * q, nb = (2 * q + 1 < 9) ? 2 * q + 1 : 2 * q;
                u32x4 pku;
                pku[0] = pk2(sc[na][0], sc[na][1]); pku[1] = pk2(sc[na][2], sc[na][3]);
                if (2 * q + 1 < 9) { pku[2] = pk2(sc[nb][0], sc[nb][1]); pku[3] = pk2(sc[nb][2], sc[nb][3]); } else { pku[2] = 0u; pku[3] = 0u; }
                const bf16x8 P = __builtin_bit_cast(bf16x8, pku);
#pragma unroll
                for (int dt = 0; dt < 4; ++dt) {
                    const u32x2 lo = *(const LAS u32x2*)(Vt + (16 * dt + fr) * 264 + 16 * (mt + na) + 4 * fq), hi = *(const LAS u32x2*)(Vt + (16 * dt + fr) * 264 + 16 * (mt + nb) + 4 * fq);
                    const u32x4 au = {lo[0], lo[1], hi[0], hi[1]};
                    o[dt] = mfma16(__builtin_bit_cast(bf16x8, au), P, o[dt]);
                }
            }
#pragma unroll
            for (int dt = 0; dt < 4; ++dt) {
                const int d0 = hq * 64 + 16 * dt + 4 * fq;
                const u32x2 gate = *(const u32x2*)(U + qrow * NIN_ + UC_BG + d0);
                const float o0 = o[dt][0] * inv * bf_lo(gate[0]), o1 = o[dt][1] * inv * bf_hi(gate[0]), o2 = o[dt][2] * inv * bf_lo(gate[1]), o3 = o[dt][3] * inv * bf_hi(gate[1]);
                u32x2 pk = {pk2(o0, o1), pk2(o2, o3)};
                *(u32x2*)(GB + qrow * 1024 + d0) = pk;
            }
        }
        __syncthreads();
    }
}

__global__ void __launch_bounds__(512, 2) mega_fwd(Params p) {
    extern __shared__ __attribute__((aligned(16))) unsigned char smem[];
    LAS unsigned char* lds = (LAS unsigned char*)smem;
    cg::grid_group grid = cg::this_grid();
    const int wg = blockIdx.x, nwg = gridDim.x, tid = otid();
    unsigned char* ws = p.ws;
    bf16_t* WIN = (bf16_t*)(ws + WS_WIN); bf16_t* WPA = (bf16_t*)(ws + WS_WPA); bf16_t* WPB = (bf16_t*)(ws + WS_WPB); bf16_t* WPC = (bf16_t*)(ws + WS_WPC); bf16_t* WOUT = (bf16_t*)(ws + WS_WOUT);
    bf16_t* U = (bf16_t*)(ws + WS_U); float* X = (float*)(ws + WS_X); bf16_t* XB = (bf16_t*)(ws + WS_XB);
    bf16_t* GA = (bf16_t*)(ws + WS_GA); bf16_t* GB = (bf16_t*)(ws + WS_GB); bf16_t* GC = (bf16_t*)(ws + WS_GC); bf16_t* MG = (bf16_t*)(ws + WS_MG);
    float* DS = (float*)(ws + WS_DS); bf16_t* SIN = (bf16_t*)(ws + WS_SIN); float* DEC = (float*)(ws + WS_DEC); float* LB = (float*)(ws + WS_LB); float* BIAS = (float*)(ws + WS_BIAS);

    for (size_t i = (size_t)wg * 512 + tid; i < (size_t)M_ * D_ / 4; i += (size_t)nwg * 512) {
        const f32x4 v = *(const f32x4*)(p.x + i * 4);
        *(f32x4*)(X + i * 4) = v;
        u32x2 pk = {pk2(v[0], v[1]), pk2(v[2], v[3])};
        *(u32x2*)(XB + i * 4) = pk;
    }
    {
        const int gt = wg * 512 + tid;
        if (gt < 1024) {
            const float a0 = p.lb_param[gt], a1 = p.lb_param[1024 + gt], a2 = p.lb_param[2048 + gt], a3 = p.lb_param[3072 + gt];
            const float mx = fmaxf(fmaxf(a0, a1), fmaxf(a2, a3));
            const float e0 = expf(a0 - mx), e1 = expf(a1 - mx), e2 = expf(a2 - mx), e3 = expf(a3 - mx);
            const float inv = 1.0f / (e0 + e1 + e2 + e3);
            LB[gt] = 0.f; LB[1024 + gt] = e1 * inv; LB[2048 + gt] = (e1 + e2) * inv; LB[3072 + gt] = (e1 + e2 + e3) * inv;
        } else if (gt < 1024 + 2048) {
            const int hh = (gt - 1024) >> 7, rel = (gt - 1024) & 127;
            int bucket = rel;
            if (rel >= 16) { const float logd = logf((float)rel / 16.0f) / logf(8.0f); int lg = 16 + (int)(logd * 16.0f); bucket = lg > 31 ? 31 : lg; }
            BIAS[hh * 128 + rel] = p.rel_bias[bucket * 16 + hh];
        }
    }
#pragma unroll 1
    for (int l = 0; l < DEPTH_; ++l) {
        transpose_convert(lds, p.w_in + (size_t)l * D_ * NIN_, WIN + (size_t)l * NIN_ * D_, D_, NIN_, wg, nwg);
        transpose_convert(lds, p.w_pa + (size_t)l * 1024 * D_, WPA + (size_t)l * D_ * 1024, 1024, D_, wg, nwg);
        transpose_convert(lds, p.w_pb + (size_t)l * 1024 * D_, WPB + (size_t)l * D_ * 1024, 1024, D_, wg, nwg);
        transpose_convert(lds, p.w_pc + (size_t)l * 1024 * D_, WPC + (size_t)l * D_ * 1024, 1024, D_, wg, nwg);
        transpose_convert(lds, p.w_out + (size_t)l * D_ * D_, WOUT + (size_t)l * D_ * D_, D_, D_, wg, nwg);
    }
    grid.sync();

#pragma unroll 1
    for (int l = 0; l < DEPTH_; ++l) {
        {
            pg8::Gemm g; g.A = XB; g.Bt = WIN + (size_t)l * NIN_ * D_; g.M = M_; g.N = NIN_; g.K = D_;
            pg8::StaticOrder S; S.init(M_, NIN_, nwg, wg);
            EpiIn E; E.U = U; E.lb = LB + l * 1024;
            pg8::gemm_phase<EpiIn, pg8::StaticOrder, false>(lds, g, S, E, nullptr);
        }
        grid.sync();
        hgrn_local_phase(lds, U, DS, DEC, wg, nwg);
        attn_phase(lds, U, GB, BIAS, p.sinks + l * 16, wg, nwg);
        conv_phase(U, GC, p.conv_w + (size_t)l * 3 * 1024, wg, nwg);
        grid.sync();
        hgrn_scan_phase(DS, DEC, SIN, wg, nwg);
        grid.sync();
        hgrn_out_phase(lds, U, SIN, GA, p.norm_g + l * 1024, wg, nwg);
        grid.sync();
#pragma unroll 1
        for (int br = 0; br < 3; ++br) {
            pg8::Gemm g; g.A = br == 0 ? GA : (br == 1 ? GB : GC); g.Bt = (br == 0 ? WPA : (br == 1 ? WPB : WPC)) + (size_t)l * D_ * 1024; g.M = M_; g.N = D_; g.K = 1024;
            pg8::StaticOrder S; S.init(M_, D_, nwg, wg);
            EpiMerge E; E.gate = U + UC_MA + 2048 * br; E.Mg = MG; E.first = (br == 0);
            pg8::gemm_phase<EpiMerge, pg8::StaticOrder, false>(lds, g, S, E, nullptr);
        }
        grid.sync();
        {
            pg8::Gemm g; g.A = MG; g.Bt = WOUT + (size_t)l * D_ * D_; g.M = M_; g.N = D_; g.K = D_;
            pg8::StaticOrder S; S.init(M_, D_, nwg, wg);
            EpiOut E; E.X = X;
            pg8::gemm_phase<EpiOut, pg8::StaticOrder, false>(lds, g, S, E, nullptr);
        }
        grid.sync();
        ln_phase(X, (l == DEPTH_ - 1) ? p.out : X, XB, p.ln_g + l * D_, p.ln_b + l * D_, wg, nwg);
        if (l != DEPTH_ - 1) grid.sync();
    }
}

extern "C" void kernel_launch(void* const* d_in, const int* in_sizes, int n_in, void* d_out, int out_size, void* d_ws, size_t ws_size, hipStream_t stream) {
    static int grid_blocks = 0;
    if (grid_blocks == 0) {
        if (n_in != 13 || out_size != M_ * D_ || ws_size < WS_END) { fprintf(stderr, "kernel_launch: unexpected shapes (n_in %d out %d ws %zu need %zu)\n", n_in, out_size, ws_size, (size_t)WS_END); grid_blocks = -1; return; }
        int dev = 0, cus = 0, per_cu = 0;
        hipGetDevice(&dev);
        hipDeviceGetAttribute(&cus, hipDeviceAttributeMultiprocessorCount, dev);
        if (hipFuncSetAttribute((const void*)mega_fwd, hipFuncAttributeMaxDynamicSharedMemorySize, LDS_BYTES) != hipSuccess) { fprintf(stderr, "kernel_launch: hipFuncSetAttribute failed\n"); grid_blocks = -1; return; }
        if (hipOccupancyMaxActiveBlocksPerMultiprocessor(&per_cu, (const void*)mega_fwd, 512, LDS_BYTES) != hipSuccess || per_cu < 1) { fprintf(stderr, "kernel_launch: occupancy query gave %d\n", per_cu); per_cu = 1; }
        (void)hipGetLastError();
        grid_blocks = cus * per_cu;
    }
    if (grid_blocks < 0) return;
    Params p{};
    p.x = (const float*)d_in[0]; p.w_in = (const float*)d_in[1]; p.w_pa = (const float*)d_in[2]; p.w_pb = (const float*)d_in[3]; p.w_pc = (const float*)d_in[4];
    p.w_out = (const float*)d_in[5]; p.lb_param = (const float*)d_in[6]; p.norm_g = (const float*)d_in[7]; p.sinks = (const float*)d_in[8]; p.conv_w = (const float*)d_in[9];
    p.rel_bias = (const float*)d_in[10]; p.ln_g = (const float*)d_in[11]; p.ln_b = (const float*)d_in[12];
    p.out = (float*)d_out; p.ws = (unsigned char*)d_ws;
    void* args[] = {&p};
    hipError_t e = hipLaunchCooperativeKernel((const void*)mega_fwd, dim3(grid_blocks), dim3(512), args, LDS_BYTES, stream);
    if (e != hipSuccess) fprintf(stderr, "cooperative launch failed: %s (grid %d)\n", hipGetErrorString(e), grid_blocks);
}
```

```cpp
#include <hip/hip_runtime.h>
#include <hip/hip_cooperative_groups.h>
#include <cstdio>
namespace cg = cooperative_groups;
__device__ __forceinline__ int otid() { int t = threadIdx.x; asm volatile("" : "+v"(t)); return t; }
#ifndef REP_PRO
#define REP_PRO 1
#define REP_GIN 1
#define REP_P2 1
#define REP_SCAN 1
#define REP_H3 1
#endif
#define MRG_B 4
#define OUT_B 2
#ifndef REP_SYNC
#define REP_SYNC 0
#endif
#define STG_IN_S 1
#define STG_IN_T 900
#define STG_MG_S 1
#define STG_MG_T 1500
#ifndef REP_MG
#define REP_MG 1
#endif
#ifndef REP_OUT
#define REP_OUT 1
#define REP_LN 1
#endif
#ifndef PROBE_ID
#define PROBE_ID 0
#define PROBE_AMP 4
#endif
#ifndef HIDE_CVT
#define HIDE_CVT 1
#endif
namespace pg8 {
#define PG8_LAS __attribute__((address_space(3)))
typedef unsigned short bf16_t;
typedef short bf16x8 __attribute__((ext_vector_type(8)));
typedef float f32x4 __attribute__((ext_vector_type(4)));
typedef unsigned u32x4 __attribute__((ext_vector_type(4)));
constexpr int BM = 256, BK = 64, HALF = 128, HTB = HALF * BK * 2  , STAGE_BYTES = 8 * HTB, NXCD = 8, WGM = 8;

__host__ __device__ __forceinline__ int lds_byte(int r, int c) { const int st = (r >> 4) * 2 + (c >> 5), rr = r & 15, cc = c & 31, ob = rr * 64 + cc * 2; return st * 1024 + (ob ^ (((ob >> 9) & 1) << 5)); }
__host__ __device__ __forceinline__ void stage_rc(int b, int& R, int& C) { const int st = b / 1024, sb = b % 1024, swz = sb ^ (((sb >> 9) & 1) << 5); R = (st >> 1) * 16 + swz / 64; C = (st & 1) * 32 + (swz % 64) / 2; }
__host__ __device__ __forceinline__ int perm32(int rho) { const int n = rho >> 4, i = rho & 15; return 8 * (i >> 2) + 4 * n + (i & 3); }

struct Unit { int pm, pn; };
struct Gemm { const bf16_t* A; const bf16_t* Bt; int M, N, K; };

struct StaticOrder {
    int nM, nN, nwg, G, c;
    __host__ __device__ void init(int M, int N, int G_, int c_) { nM = M / BM; nN = N / BM; nwg = nM * nN; G = G_; c = c_; }
    __host__ __device__ bool next(int i, Unit& u) const {
        const long L = (long)i * G + c; if (L >= nwg) return false;
        int wgid = (int)L; { const int q = nwg / NXCD, r = nwg % NXCD, xcd = wgid % NXCD, off = wgid / NXCD; wgid = (xcd < r ? xcd * (q + 1) : r * (q + 1) + (xcd - r) * q) + off; }
        const int nig = WGM * nN, gid = wgid / nig, fm = gid * WGM, gsz = (nM - fm) < WGM ? (nM - fm) : WGM;
        u.pm = fm + ((wgid % nig) % gsz); u.pn = (wgid % nig) / gsz; return true;
    }
    __device__ __forceinline__ void a_ready(const Unit&) const {}
    __device__ __forceinline__ void done(const Unit&) const {}
};

template <class Epi, class Sched, bool STAMP = false>
__device__ __forceinline__ void gemm_phase(PG8_LAS unsigned char* lds, const Gemm g, const Sched& S, const Epi& E, unsigned long long* stamps) {
    const int tid = otid(), wid = __builtin_amdgcn_readfirstlane(tid >> 6), lane = tid & 63, wr = wid >> 2, wc = wid & 3, fr = lane & 15, fq = lane >> 4;
    const int K = g.K, nt = K / BK;
    int ts_lo = 0, ts_hi = 0, nts = 0; const unsigned long long rt_entry = STAMP ? (unsigned long long)wall_clock64() : 0ull;
#define PG8_STAMP() do { if (STAMP && wid == 0 && nts < 64) { const unsigned long long _c = (unsigned long long)clock64(); \
        ts_lo = (lane == nts) ? (int)(unsigned)_c : ts_lo; ts_hi = (lane == nts) ? (int)(unsigned)(_c >> 32) : ts_hi; ++nts; } } while (0)
    PG8_STAMP();
    unsigned voffA[2], voffB[2];
#pragma unroll
    for (int i = 0; i < 2; ++i) { int R, C; stage_rc(tid * 16 + i * 8192, R, C); const int Rb = Epi::PERM ? ((R & ~31) + perm32(R & 31)) : R;
        voffA[i] = (unsigned)(R * K + C) * 2u; voffB[i] = (unsigned)(Rb * K + C) * 2u; }
    const size_t kstep = (size_t)(BK * 2);
    const size_t hstep = (size_t)HALF * K * 2;
    const size_t tstep = 2 * hstep;
    const unsigned ldsw = (unsigned)wid * 1024u;
    const int aoff = lds_byte(wr * 64 + fr, fq * 8), boff = lds_byte(wc * 32 + fr, fq * 8);
#define PG8_SA(b, h) (((b) * 2 + (h)) * HTB)
#define PG8_SB(b, h) ((4 + (b) * 2 + (h)) * HTB)
#define PG8_STAGE(bufoff, gbase, voff) do { _Pragma("unroll") for (int _i = 0; _i < 2; ++_i) \
        __builtin_amdgcn_global_load_lds((const unsigned*)((const char*)(gbase) + (voff)[_i]), (PG8_LAS unsigned*)(lds + (bufoff) + ldsw + _i * 8192), 16, 0, 0); } while (0)
#define PG8_LDA(dst, b, h) do { _Pragma("unroll") for (int m = 0; m < 4; ++m) _Pragma("unroll") for (int k = 0; k < 2; ++k) dst[m][k] = *(const PG8_LAS bf16x8*)(lds + PG8_SA(b, h) + aoff + m * 2048 + k * 1024); } while (0)
#define PG8_LDB(dst, b, h) do { _Pragma("unroll") for (int n = 0; n < 2; ++n) _Pragma("unroll") for (int k = 0; k < 2; ++k) dst[n][k] = *(const PG8_LAS bf16x8*)(lds + PG8_SB(b, h) + boff + n * 2048 + k * 1024); } while (0)
#define PG8_MMA(ai, bj, At, Bt) do { __builtin_amdgcn_s_setprio(1); _Pragma("unroll") for (int m = 0; m < 4; ++m) _Pragma("unroll") for (int n = 0; n < 2; ++n) _Pragma("unroll") for (int k = 0; k < 2; ++k) \
        acc[ai][bj][m][n] = __builtin_amdgcn_mfma_f32_16x16x32_bf16(Bt[n][k], At[m][k], acc[ai][bj][m][n], 0, 0, 0); __builtin_amdgcn_s_setprio(0); } while (0)
#define PG8_WAIT_V(n) asm volatile("s_waitcnt vmcnt(" #n ")" ::: "memory")
#define PG8_WAIT_L(n) asm volatile("s_waitcnt lgkmcnt(" #n ")" ::: "memory")
#define PG8_BAR __builtin_amdgcn_s_barrier()
#define PG8_SCHED __builtin_amdgcn_sched_barrier(0)
    Unit cur, nxt; int ui = 0;
    if (!S.next(0, cur)) return;
    f32x4 acc[2][2][4][2];
#pragma unroll
    for (int a = 0; a < 2; ++a)
#pragma unroll
        for (int b = 0; b < 2; ++b)
#pragma unroll
            for (int m = 0; m < 4; ++m)
#pragma unroll
                for (int n = 0; n < 2; ++n) acc[a][b][m][n] = (f32x4){0.f, 0.f, 0.f, 0.f};
    bf16x8 At[4][2], B0[2][2], B1[2][2];
    const char* cA = (const char*)g.A + (size_t)cur.pm * tstep; const char* cB = (const char*)g.Bt + (size_t)cur.pn * tstep;
    S.a_ready(cur);
    PG8_STAGE(PG8_SB(0, 0), cB, voffB); PG8_STAGE(PG8_SA(0, 0), cA, voffA); PG8_STAGE(PG8_SB(0, 1), cB + hstep, voffB); PG8_STAGE(PG8_SA(0, 1), cA + hstep, voffA);
    if (wr == 1) PG8_BAR;
    PG8_WAIT_V(4); PG8_BAR;
    PG8_STAGE(PG8_SB(1, 0), cB + kstep, voffB); PG8_STAGE(PG8_SA(1, 0), cA + kstep, voffA); PG8_STAGE(PG8_SB(1, 1), cB + hstep + kstep, voffB);
    PG8_WAIT_V(6); PG8_BAR;
    PG8_STAMP();
    for (;;) {
        const bool has_next = S.next(ui + 1, nxt);
        const char* nA = has_next ? (const char*)g.A + (size_t)nxt.pm * tstep : cA; const char* nB = has_next ? (const char*)g.Bt + (size_t)nxt.pn * tstep : cB;
        for (int t = 0; t < nt; t += 2) {
            const bool last = (t == nt - 2);
            const char* a1 = cA + (size_t)(t + 1) * kstep;
            const char* a2 = last ? nA : cA + (size_t)(t + 2) * kstep; const char* b2 = last ? nB : cB + (size_t)(t + 2) * kstep;
            const char* a3 = a2 + kstep; const char* b3 = b2 + kstep;
            if (last && has_next) S.a_ready(nxt);
            PG8_LDB(B0, 0, 0); PG8_SCHED; PG8_LDA(At, 0, 0); PG8_STAGE(PG8_SA(1, 1), a1 + hstep, voffA);
            PG8_WAIT_L(8); PG8_BAR; PG8_WAIT_L(0); PG8_MMA(0, 0, At, B0); PG8_BAR; PG8_SCHED;
            PG8_LDB(B1, 0, 1); PG8_STAGE(PG8_SB(0, 0), b2, voffB);
            PG8_BAR; PG8_WAIT_L(0); PG8_MMA(0, 1, At, B1); PG8_BAR;
            PG8_LDA(At, 0, 1); PG8_STAGE(PG8_SA(0, 0), a2, voffA);
            PG8_BAR; PG8_WAIT_L(0); PG8_MMA(1, 0, At, B0); PG8_BAR; PG8_SCHED;
            PG8_STAGE(PG8_SB(0, 1), b2 + hstep, voffB);
            PG8_WAIT_V(6); PG8_BAR; PG8_MMA(1, 1, At, B1); PG8_BAR;
            PG8_LDB(B0, 1, 0); PG8_SCHED; PG8_LDA(At, 1, 0); PG8_STAGE(PG8_SA(0, 1), a2 + hstep, voffA);
            PG8_WAIT_L(8); PG8_BAR; PG8_WAIT_L(0); PG8_MMA(0, 0, At, B0); PG8_BAR; PG8_SCHED;
            PG8_LDB(B1, 1, 1); PG8_STAGE(PG8_SB(1, 0), b3, voffB);
            PG8_BAR; PG8_WAIT_L(0); PG8_MMA(0, 1, At, B1); PG8_BAR;
            PG8_LDA(At, 1, 1); PG8_STAGE(PG8_SA(1, 0), a3, voffA);
            PG8_BAR; PG8_WAIT_L(0); PG8_MMA(1, 0, At, B0); PG8_BAR; PG8_SCHED;
            PG8_STAGE(PG8_SB(1, 1), b3 + hstep, voffB);
            PG8_WAIT_V(6); PG8_BAR; PG8_MMA(1, 1, At, B1); PG8_BAR;
        }
        PG8_STAMP();
        if constexpr (!Epi::AFTER_DRAIN) { E(acc, cur, wr, wc, fr, fq); S.done(cur); }
        PG8_STAMP();
        if (!has_next) break;
#pragma unroll
        for (int a = 0; a < 2; ++a)
#pragma unroll
            for (int b = 0; b < 2; ++b)
#pragma unroll
                for (int m = 0; m < 4; ++m)
#pragma unroll
                    for (int n = 0; n < 2; ++n) acc[a][b][m][n] = (f32x4){0.f, 0.f, 0.f, 0.f};
        cur = nxt; cA = nA; cB = nB; ++ui;
    }
    PG8_WAIT_V(0);
    if (wr == 0) PG8_BAR;
    PG8_BAR;
    if constexpr (Epi::AFTER_DRAIN) { E.fused(acc, cur, wr, wc, fr, fq, lds, wid, lane); S.done(cur); }
    PG8_STAMP();
    if (STAMP && wid == 0) { stamps[lane] = lane < nts ? (((unsigned long long)(unsigned)ts_hi << 32) | (unsigned)ts_lo) : 0ull;
        if (lane == 62) stamps[62] = rt_entry; if (lane == 63) stamps[63] = (unsigned long long)wall_clock64(); }
#undef PG8_STAMP
#undef PG8_SA
#undef PG8_SB
#undef PG8_STAGE
#undef PG8_LDA
#undef PG8_LDB
#undef PG8_MMA
#undef PG8_WAIT_V
#undef PG8_WAIT_L
#undef PG8_BAR
#undef PG8_SCHED
}
}

#define LAS __attribute__((address_space(3)))
#define DI __device__ __forceinline__
using pg8::bf16_t; using pg8::bf16x8; using pg8::f32x4; using pg8::u32x4;
typedef float f32x2 __attribute__((ext_vector_type(2)));
typedef unsigned u32x2 __attribute__((ext_vector_type(2)));
typedef short s16x4 __attribute__((ext_vector_type(4)));
typedef __bf16 bf2_t __attribute__((ext_vector_type(2)));

constexpr int D_ = 2048, SEQ_ = 8192, M_ = 16384, DEPTH_ = 4, NIN_ = 16896;
constexpr int UC_AQ = 0, UC_AF = 1024, UC_AI = 2048, UC_AG = 3072, UC_BQ = 4096, UC_BK = 5120, UC_BV = 5376, UC_BG = 5632,
              UC_CB = 6656, UC_CC = 7680, UC_CX = 8704, UC_CG = 9728, UC_MA = 10752;
constexpr float ALPHA_ = 1.681792830507429f;
constexpr int LDS_BYTES = 147456;

constexpr size_t SZ_WIN = (size_t)DEPTH_ * NIN_ * D_ * 2, SZ_WP = (size_t)DEPTH_ * 2048 * 1024 * 2, SZ_WOUT = (size_t)DEPTH_ * 2048 * 2048 * 2;
constexpr size_t WS_WIN = 0, WS_WPA = WS_WIN + SZ_WIN, WS_WPB = WS_WPA + SZ_WP, WS_WPC = WS_WPB + SZ_WP, WS_WOUT = WS_WPC + SZ_WP;
constexpr size_t WS_U = WS_WOUT + SZ_WOUT, WS_X = WS_U + (size_t)M_ * NIN_ * 2, WS_XB = WS_X + (size_t)M_ * D_ * 4, WS_GA = WS_XB + (size_t)M_ * D_ * 2;
constexpr size_t WS_GB = WS_GA + (size_t)M_ * 1024 * 2, WS_GC = WS_GB + (size_t)M_ * 1024 * 2, WS_MG = WS_GC + (size_t)M_ * 1024 * 2;
constexpr size_t WS_DS = WS_MG + (size_t)M_ * D_ * 2, WS_SIN = WS_DS + (size_t)2048 * 16384 * 4, WS_DEC = WS_SIN + (size_t)2048 * 16384 * 2;
constexpr size_t WS_LB = WS_DEC + (size_t)2048 * 128 * 4, WS_BIAS = WS_LB + 4 * 1024 * 4, WS_BAR = WS_BIAS + 16 * 128 * 4, WS_GT = WS_BAR + 16384, WS_MP = WS_GT + (size_t)3 * 512 * 65536 * 2, WS_US = WS_MP + (size_t)512 * 65536 * 2, WS_END = WS_US + (size_t)208 * M_ * 64;

struct Params {
    const float* x; const float* w_in; const float* w_pa; const float* w_pb; const float* w_pc; const float* w_out; const float* lb_param;
    const float* norm_g; const float* sinks; const float* conv_w; const float* rel_bias; const float* ln_g; const float* ln_b;
    float* out; unsigned char* ws;
};

DI float bf_lo(unsigned u) { return __uint_as_float(u << 16); }
DI float bf_hi(unsigned u) { return __uint_as_float(u & 0xffff0000u); }
DI float bf1(bf16_t h) { return __uint_as_float(((unsigned)h) << 16); }
DI unsigned pk2(float lo, float hi) { f32x2 v = {lo, hi}; return __builtin_bit_cast(unsigned, __builtin_convertvector(v, bf2_t)); }
DI bf16_t f2bf(float x) { return (bf16_t)(pk2(x, 0.f) & 0xffffu); }
DI float fsigmoid(float x) { return __builtin_amdgcn_rcpf(1.0f + __expf(-x)); }
DI void unpack8(const u32x4 v, float (&o)[8]) {
    o[0] = bf_lo(v[0]); o[1] = bf_hi(v[0]); o[2] = bf_lo(v[1]); o[3] = bf_hi(v[1]); o[4] = bf_lo(v[2]); o[5] = bf_hi(v[2]); o[6] = bf_lo(v[3]); o[7] = bf_hi(v[3]);
}
DI size_t us_off(int row, int col) { return ((size_t)(col >> 5) * M_ + (size_t)row) * 32 + (size_t)(col & 31); }
DI void st_nt(u32x4* p, u32x4 v) { __builtin_nontemporal_store(v, p); }
DI void st_nt(u32x2* p, u32x2 v) { __builtin_nontemporal_store(v, p); }
DI u32x4 ld_nt(const u32x4* p) { return __builtin_nontemporal_load(p); }
DI u32x2 ld_nt(const u32x2* p) { return __builtin_nontemporal_load(p); }
template <int OA, int OB> DI void tr_read8(unsigned base, u32x2 (&lo)[4], u32x2 (&hi)[4]) {
    asm volatile("ds_read_b64_tr_b16 %0, %8 offset:%9\n\tds_read_b64_tr_b16 %1, %8 offset:%10\n\tds_read_b64_tr_b16 %2, %8 offset:%11\n\tds_read_b64_tr_b16 %3, %8 offset:%12\n\t"
                 "ds_read_b64_tr_b16 %4, %8 offset:%13\n\tds_read_b64_tr_b16 %5, %8 offset:%14\n\tds_read_b64_tr_b16 %6, %8 offset:%15\n\tds_read_b64_tr_b16 %7, %8 offset:%16\n\ts_waitcnt lgkmcnt(0)"
                 : "=&v"(lo[0]), "=&v"(lo[1]), "=&v"(lo[2]), "=&v"(lo[3]), "=&v"(hi[0]), "=&v"(hi[1]), "=&v"(hi[2]), "=&v"(hi[3])
                 : "v"(base), "n"(OA), "n"(OA + 32), "n"(OA + 64), "n"(OA + 96), "n"(OB), "n"(OB + 32), "n"(OB + 64), "n"(OB + 96)
                 : "memory");
}
DI f32x4 mfma16(bf16x8 a, bf16x8 b, f32x4 c) { return __builtin_amdgcn_mfma_f32_16x16x32_bf16(a, b, c, 0, 0, 0); }

struct EpiIn {
    static constexpr bool PERM = true, AFTER_DRAIN = false;
    bf16_t* U; const float* lb; bf16_t* GT; bf16_t* US;
    template <int MODE> DI void run(const f32x4 (&acc)[2][2][4][2], const pg8::Unit& u, int wr, int wc, int fr, int fq, float scale) const {
        const bool strip = u.pn < 26;
        const int row0 = u.pm * 256 + wr * 64 + fr, col0 = u.pn * 256 + wc * 32 + 8 * fq;
        f32x4 l0[2], l1[2];
#pragma unroll
        for (int bj = 0; bj < 2; ++bj) {
            if (MODE == 3) { l0[bj] = *(const f32x4*)(lb + (col0 - UC_AF) + bj * 128); l1[bj] = *(const f32x4*)(lb + (col0 - UC_AF) + bj * 128 + 4); }
            else { l0[bj] = (f32x4){0.f, 0.f, 0.f, 0.f}; l1[bj] = l0[bj]; }
        }
#pragma unroll
        for (int ai = 0; ai < 2; ++ai)
#pragma unroll
            for (int m = 0; m < 4; ++m) {
                const int row = row0 + ai * 128 + m * 16;
#pragma unroll
                for (int bj = 0; bj < 2; ++bj) {
                    bf16_t* dst = strip ? US + us_off(row, col0 + bj * 128) : U + (size_t)row * NIN_ + col0 + bj * 128;
                    float o[8];
#pragma unroll
                    for (int e = 0; e < 8; ++e) {
                        const float v = (e < 4) ? acc[ai][bj][m][0][e & 3] : acc[ai][bj][m][1][e & 3];
                        const float lbv = (e < 4) ? l0[bj][e & 3] : l1[bj][e & 3];
                        float r;
                        if (MODE == 0) r = v * scale;
                        else if (MODE == 1) r = v * fsigmoid(v) * scale;
                        else if (MODE == 2) r = fsigmoid(v);
                        else r = __logf(lbv + (1.0f - lbv) * fsigmoid(v));
                        o[e] = r;
                    }
                    u32x4 pk = {pk2(o[0], o[1]), pk2(o[2], o[3]), pk2(o[4], o[5]), pk2(o[6], o[7])};
                    st_nt((u32x4*)dst, pk);
                }
            }
    }
    DI void operator()(const f32x4 (&acc)[2][2][4][2], const pg8::Unit& u, int wr, int wc, int fr, int fq) const {
        const int pn = u.pn;
        if (pn < 4) run<1>(acc, u, wr, wc, fr, fq, 0.08838834764831845f);
        else if (pn < 8) run<3>(acc, u, wr, wc, fr, fq, 1.f);
        else if (pn < 12) run<0>(acc, u, wr, wc, fr, fq, 1.f);
        else if (pn < 16) run<1>(acc, u, wr, wc, fr, fq, 1.f);
        else if (pn < 20) run<0>(acc, u, wr, wc, fr, fq, 0.125f);
        else if (pn < 22) run<0>(acc, u, wr, wc, fr, fq, 1.f);
        else if (pn < 26) run<1>(acc, u, wr, wc, fr, fq, 1.f);
        else if (pn < 42) {
            const bool isH = pn < 34;
            bf16_t* dstb = (isH ? U : U + (size_t)M_ * 1024) + (size_t)((pn - (isH ? 26 : 34)) * 128 + wc * 32 + 8 * fq);
            const int row0 = u.pm * 256 + wr * 64 + fr;
#pragma unroll
            for (int ai = 0; ai < 2; ++ai)
#pragma unroll
                for (int m = 0; m < 4; ++m) {
                    float o[8];
#pragma unroll
                    for (int e = 0; e < 8; ++e) {
                        const float a = (e < 4) ? acc[ai][0][m][0][e & 3] : acc[ai][0][m][1][e & 3], bq = (e < 4) ? acc[ai][1][m][0][e & 3] : acc[ai][1][m][1][e & 3];
                        o[e] = isH ? a * bq : a * (bq * fsigmoid(bq));
                    }
                    u32x4 pk = {pk2(o[0], o[1]), pk2(o[2], o[3]), pk2(o[4], o[5]), pk2(o[6], o[7])};
                    st_nt((u32x4*)(dstb + (size_t)(row0 + ai * 128 + m * 16) * 1024), pk);
                }
        }
        else {
            unsigned char* tp = (unsigned char*)GT + (size_t)((((pn - 42) >> 3) * 64 + u.pm) * 8 + ((pn - 42) & 7)) * 65536 + (size_t)(((wr * 4 + wc) * 64 + fq * 16 + fr) * 8);
#pragma unroll
            for (int ai = 0; ai < 2; ++ai)
#pragma unroll
                for (int m = 0; m < 4; ++m)
#pragma unroll
                    for (int bj = 0; bj < 2; ++bj) {
                        const f32x4 v0 = acc[ai][bj][m][0], v1 = acc[ai][bj][m][1];
                        unsigned q[8];
#pragma unroll
                        for (int e = 0; e < 4; ++e) { q[e] = (unsigned)(fsigmoid(v0[e]) * 255.0f + 0.5f); q[4 + e] = (unsigned)(fsigmoid(v1[e]) * 255.0f + 0.5f); }
                        u32x2 pk = {q[0] | (q[1] << 8) | (q[2] << 16) | (q[3] << 24), q[4] | (q[5] << 8) | (q[6] << 16) | (q[7] << 24)};
                        st_nt((u32x2*)(tp + ((ai * 4 + m) * 2 + bj) * 4096), pk);
                    }
        }
    }
};
struct EpiMerge {
    static constexpr bool PERM = true, AFTER_DRAIN = false;
    const unsigned char* GTb; bf16_t* MP; bf16_t* Mg; int br;
    DI void operator()(const f32x4 (&acc)[2][2][4][2], const pg8::Unit& u, int wr, int wc, int fr, int fq) const {
        const int row0 = u.pm * 256 + wr * 64 + fr, col0 = u.pn * 256 + wc * 32 + 8 * fq;
        const size_t toff = (size_t)(u.pm * 8 + u.pn) * 65536 + (size_t)(((wr * 4 + wc) * 64 + fq * 16 + fr) * 8);
        const unsigned char* gp = GTb + toff; bf16_t* pp = MP + toff;
        u32x2 gv[16];
#pragma unroll
        for (int r = 0; r < 16; ++r) gv[r] = ld_nt((const u32x2*)(gp + r * 4096));
#pragma unroll
        for (int r0 = 0; r0 < 16; r0 += 8) {
            u32x4 pv[8];
#pragma unroll
            for (int rr = 0; rr < 8; ++rr) { pv[rr] = (u32x4){0u, 0u, 0u, 0u}; if (br != 0) pv[rr] = ld_nt((const u32x4*)(pp + (r0 + rr) * 4096)); }
#pragma unroll
            for (int rr = 0; rr < 8; ++rr) {
                const int r = r0 + rr, ai = r >> 3, m = (r >> 1) & 3, bj = r & 1;
                float g[8], p[8], o[8];
#pragma unroll
                for (int e = 0; e < 8; ++e) g[e] = (float)((gv[r][e >> 2] >> (8 * (e & 3))) & 0xffu) * (1.0f / 255.0f);
                unpack8(pv[rr], p);
#pragma unroll
                for (int e = 0; e < 8; ++e) { const float a = (e < 4) ? acc[ai][bj][m][0][e & 3] : acc[ai][bj][m][1][e & 3]; o[e] = p[e] + g[e] * a; }
                u32x4 pk = {pk2(o[0], o[1]), pk2(o[2], o[3]), pk2(o[4], o[5]), pk2(o[6], o[7])};
                if (br != 2) st_nt((u32x4*)(pp + r * 4096), pk);
                else *(u32x4*)(Mg + (size_t)(row0 + ai * 128 + m * 16) * D_ + col0 + bj * 128) = pk;
            }
        }
    }
};
struct EpiOut {
    static constexpr bool PERM = true, AFTER_DRAIN = false;
    bf16_t* Y;
    DI void operator()(const f32x4 (&acc)[2][2][4][2], const pg8::Unit& u, int wr, int wc, int fr, int fq) const {
        const int row0 = u.pm * 256 + wr * 64 + fr, col0 = u.pn * 256 + wc * 32 + 8 * fq;
#pragma unroll
        for (int ai = 0; ai < 2; ++ai)
#pragma unroll
            for (int m = 0; m < 4; ++m) {
                bf16_t* rowp = Y + (size_t)(row0 + ai * 128 + m * 16) * D_ + col0;
#pragma unroll
                for (int bj = 0; bj < 2; ++bj) {
                    const f32x4 v0 = acc[ai][bj][m][0], v1 = acc[ai][bj][m][1];
                    u32x4 pk = {pk2(v0[0], v0[1]), pk2(v0[2], v0[3]), pk2(v1[0], v1[1]), pk2(v1[2], v1[3])};
                    st_nt((u32x4*)(rowp + bj * 128), pk);
                }
            }
    }
};

DI int win_block_perm(int b) { if (b < 52 || b >= 84) return b; const int s4 = (b - 52) >> 3, t = (b - 52) & 7; return s4 == 1 ? 52 + 2 * t : (s4 == 2 ? 53 + 2 * t : (s4 == 0 ? 68 + 2 * t : 69 + 2 * t)); }
template <bool PERMW = false> DI void transpose_convert(LAS unsigned char* lds, const float* W, bf16_t* Wt, int K, int N, int wg, int nwg, int t_lo = 0, int t_hi = 1 << 30) {
    LAS float* T = (LAS float*)lds;
    const int tid = otid(), tn = N / 128, nt = (tn * (K / 64)) < t_hi ? (tn * (K / 64)) : t_hi;
    f32x4 nv[4];
#define TC_LOAD(t_) do { const int _k0 = ((t_) / tn) * 64, _n0 = ((t_) % tn) * 128; \
        _Pragma("unroll") for (int e = 0; e < 4; ++e) { const int idx = tid + 512 * e, kk = idx >> 5, n4 = (idx & 31) * 4; nv[e] = *(const f32x4*)(W + (size_t)(_k0 + kk) * N + _n0 + n4); } } while (0)
    if (t_lo + wg < nt) TC_LOAD(t_lo + wg);
    for (int t = t_lo + wg; t < nt; t += nwg) {
        const int k0 = (t / tn) * 64, n0 = (t % tn) * 128;
#pragma unroll
        for (int e = 0; e < 4; ++e) {
            const int idx = tid + 512 * e, kk = idx >> 5, n4 = (idx & 31) * 4;
            T[kk * 129 + n4 + 0] = nv[e][0]; T[kk * 129 + n4 + 1] = nv[e][1]; T[kk * 129 + n4 + 2] = nv[e][2]; T[kk * 129 + n4 + 3] = nv[e][3];
        }
        __syncthreads();
        if (t + nwg < nt) TC_LOAD(t + nwg);
#pragma unroll
        for (int e = 0; e < 2; ++e) {
            const int idx = tid + 512 * e, n = idx >> 3, kg = idx & 7;
            float o[8];
#pragma unroll
            for (int j = 0; j < 8; ++j) o[j] = T[(kg * 8 + j) * 129 + n];
            u32x4 pk = {pk2(o[0], o[1]), pk2(o[2], o[3]), pk2(o[4], o[5]), pk2(o[6], o[7])};
            const int nd = PERMW ? win_block_perm(n0 >> 7) * 128 + n : n0 + n;
            *(u32x4*)(Wt + (size_t)nd * K + k0 + kg * 8) = pk;
        }
        __syncthreads();
    }
#undef TC_LOAD
}
constexpr int CVT_SPLIT = 2688;
DI void convert_layer_weights(LAS unsigned char* lds, const Params& p, unsigned char* ws, int l, int wg, int nwg, int part) {
    if (part != 2) transpose_convert<true>(lds, p.w_in + (size_t)l * D_ * NIN_, (bf16_t*)(ws + WS_WIN) + (size_t)l * NIN_ * D_, D_, NIN_, wg, nwg, 0, part == 0 ? (1 << 30) : CVT_SPLIT);
    if (part == 1) return;
    if (part == 2) transpose_convert<true>(lds, p.w_in + (size_t)l * D_ * NIN_, (bf16_t*)(ws + WS_WIN) + (size_t)l * NIN_ * D_, D_, NIN_, wg, nwg, CVT_SPLIT);
    transpose_convert(lds, p.w_pa + (size_t)l * 1024 * D_, (bf16_t*)(ws + WS_WPA) + (size_t)l * D_ * 1024, 1024, D_, wg, nwg);
    transpose_convert(lds, p.w_pb + (size_t)l * 1024 * D_, (bf16_t*)(ws + WS_WPB) + (size_t)l * D_ * 1024, 1024, D_, wg, nwg);
    transpose_convert(lds, p.w_pc + (size_t)l * 1024 * D_, (bf16_t*)(ws + WS_WPC) + (size_t)l * D_ * 1024, 1024, D_, wg, nwg);
    transpose_convert(lds, p.w_out + (size_t)l * D_ * D_, (bf16_t*)(ws + WS_WOUT) + (size_t)l * D_ * D_, D_, D_, wg, nwg);
}

DI float wave_sum(float v) {
#pragma unroll
    for (int o = 32; o >= 1; o >>= 1) v += __shfl_xor(v, o);
    return v;
}

template <bool FIRST, bool LAST> DI void ln_phase(const float* Xin, const bf16_t* Y, float* out, bf16_t* XB, unsigned char* XL, const float* g, const float* b, int wg, int nwg) {
    const int tid = otid(), lane = tid & 63, wave = tid >> 6;
    f32x4 nx[8]; u32x2 ny[8], nh[8]; unsigned nl[8];
#define LN_LOAD(row_) do { const size_t _ro = (size_t)(row_) * D_; _Pragma("unroll") for (int e = 0; e < 8; ++e) { const int c = e * 256 + lane * 4; ny[e] = *(const u32x2*)(Y + _ro + c); \
        if (FIRST) nx[e] = *(const f32x4*)(Xin + _ro + c); else { nh[e] = *(const u32x2*)(XB + _ro + c); nl[e] = *(const unsigned*)(XL + _ro + c); } } } while (0)
    f32x4 gg8[8], bb8[8];
#pragma unroll
    for (int e = 0; e < 8; ++e) { gg8[e] = *(const f32x4*)(g + e * 256 + lane * 4); bb8[e] = *(const f32x4*)(b + e * 256 + lane * 4); }
    int row = wg * 8 + wave;
    if (row < M_) LN_LOAD(row);
    for (; row < M_; row += nwg * 8) {
        const size_t ro = (size_t)row * D_;
        f32x4 v[8];
        float s = 0.f;
#pragma unroll
        for (int e = 0; e < 8; ++e) {
            if (FIRST) v[e] = nx[e];
            else {
                const int w = (int)nl[e];
                v[e] = (f32x4){bf_lo(nh[e][0]) + (float)((w << 24) >> 24) * (1.0f / 8192.0f), bf_hi(nh[e][0]) + (float)((w << 16) >> 24) * (1.0f / 8192.0f),
                               bf_lo(nh[e][1]) + (float)((w << 8) >> 24) * (1.0f / 8192.0f), bf_hi(nh[e][1]) + (float)(w >> 24) * (1.0f / 8192.0f)};
            }
            const f32x4 yy = {bf_lo(ny[e][0]), bf_hi(ny[e][0]), bf_lo(ny[e][1]), bf_hi(ny[e][1])};
            v[e] = v[e] * ALPHA_ + yy;
            s += (v[e][0] + v[e][1]) + (v[e][2] + v[e][3]);
        }
        if (row + nwg * 8 < M_) LN_LOAD(row + nwg * 8);
        const float mu = wave_sum(s) * (1.0f / 2048.0f);
        float ss = 0.f;
#pragma unroll
        for (int e = 0; e < 8; ++e) { v[e] = v[e] - mu; ss += (v[e][0] * v[e][0] + v[e][1] * v[e][1]) + (v[e][2] * v[e][2] + v[e][3] * v[e][3]); }
        const float rstd = rsqrtf(wave_sum(ss) * (1.0f / 2048.0f) + 1e-5f);
#pragma unroll
        for (int e = 0; e < 8; ++e) {
            const int c = e * 256 + lane * 4;
            const f32x4 y = v[e] * rstd * gg8[e] + bb8[e];
            if (LAST) *(f32x4*)(out + ro + c) = y;
            else {
                const u32x2 hi = {pk2(y[0], y[1]), pk2(y[2], y[3])};
                const float d0 = fminf(fmaxf(rintf((y[0] - bf_lo(hi[0])) * 8192.0f), -127.f), 127.f), d1 = fminf(fmaxf(rintf((y[1] - bf_hi(hi[0])) * 8192.0f), -127.f), 127.f);
                const float d2 = fminf(fmaxf(rintf((y[2] - bf_lo(hi[1])) * 8192.0f), -127.f), 127.f), d3 = fminf(fmaxf(rintf((y[3] - bf_hi(hi[1])) * 8192.0f), -127.f), 127.f);
                const unsigned lo = ((unsigned)(int)d0 & 0xffu) | (((unsigned)(int)d1 & 0xffu) << 8) | (((unsigned)(int)d2 & 0xffu) << 16) | ((unsigned)(int)d3 << 24);
                *(u32x2*)(XB + ro + c) = hi; *(unsigned*)(XL + ro + c) = lo;
            }
        }
    }
#undef LN_LOAD
}

DI void conv_phase(const bf16_t* HB, const bf16_t* PB, bf16_t* GC, const float* cw, int wg, int nwg) {
    for (int task = wg * 512 + otid(); task < 131072; task += nwg * 512) {
        const int ch0 = (task & 127) * 8, tok0 = (task >> 7) * 16;
        float w0[8], w1[8], w2[8], h1[8], h2[8];
#pragma unroll
        for (int e = 0; e < 8; ++e) { w0[e] = cw[ch0 + e]; w1[e] = cw[1024 + ch0 + e]; w2[e] = cw[2048 + ch0 + e]; h1[e] = 0.f; h2[e] = 0.f; }
        if ((tok0 & (SEQ_ - 1)) != 0) { unpack8(*(const u32x4*)(HB + (size_t)(tok0 - 1) * 1024 + ch0), h1); unpack8(*(const u32x4*)(HB + (size_t)(tok0 - 2) * 1024 + ch0), h2); }
        u32x4 nh, np;
        nh = *(const u32x4*)(HB + (size_t)tok0 * 1024 + ch0); np = *(const u32x4*)(PB + (size_t)tok0 * 1024 + ch0);
#pragma unroll 2
        for (int i = 0; i < 16; ++i) {
            float h0[8], pb[8], o[8];
            unpack8(nh, h0); unpack8(np, pb);
            if (i < 15) { nh = *(const u32x4*)(HB + (size_t)(tok0 + i + 1) * 1024 + ch0); np = *(const u32x4*)(PB + (size_t)(tok0 + i + 1) * 1024 + ch0); }
#pragma unroll
            for (int e = 0; e < 8; ++e) {
                o[e] = pb[e] * (w0[e] * h2[e] + w1[e] * h1[e] + w2[e] * h0[e]);
                h2[e] = h1[e]; h1[e] = h0[e];
            }
            u32x4 pk = {pk2(o[0], o[1]), pk2(o[2], o[3]), pk2(o[4], o[5]), pk2(o[6], o[7])};
            *(u32x4*)(GC + (size_t)(tok0 + i) * 1024 + ch0) = pk;
        }
    }
}

constexpr int HL_G = 0, HL_B = 32768, HL_TOT = 65536, HL_RED = 67584;
constexpr int H1_VT = 68096, H1_KET = H1_VT + 128 * 72 * 2;
constexpr int H3_QE = 68096, H3_QM = H3_QE + 64 * 136 * 2, H3_KM = H3_QM + 64 * 136 * 2, H3_VT = H3_KM + 64 * 136 * 2;
static_assert(H3_VT + 128 * 72 * 2 <= LDS_BYTES, "LDS");

struct HStage { u32x4 g[2], v[2], q[2]; };
template <bool WITH_Q> DI void hgrn_load(HStage& st, const bf16_t* U, int it, int tid) {
    const int c = it & 127, bh = it >> 7, b = bh >> 3, h = bh & 7, row0 = b * SEQ_ + c * 64;
#pragma unroll
    for (int e = 0; e < 2; ++e) {
        const int id = tid + 512 * e, t = id >> 4, c8 = (id & 15) * 8;
        const bf16_t* up = U + us_off(row0 + t, h * 128 + c8);
        st.g[e] = *(const u32x4*)(up + (size_t)(UC_AF >> 5) * M_ * 32); st.v[e] = *(const u32x4*)(up + (size_t)(UC_AI >> 5) * M_ * 32);
        if (WITH_Q) st.q[e] = *(const u32x4*)(up + (size_t)(UC_AQ >> 5) * M_ * 32);
    }
}
template <bool WITH_Q> DI void hgrn_commit(const HStage& st, LAS unsigned char* lds, int vt_off, int q_off, int tid) {
    LAS float* gL = (LAS float*)(lds + HL_G); LAS float* bL = (LAS float*)(lds + HL_B); LAS float* tot = (LAS float*)(lds + HL_TOT);
    LAS bf16_t* vT = (LAS bf16_t*)(lds + vt_off);
#pragma unroll
    for (int e = 0; e < 2; ++e) {
        const int id = tid + 512 * e, t = id >> 4, c8 = (id & 15) * 8;
        float gf[8]; unpack8(st.g[e], gf);
        *(LAS f32x4*)(gL + t * 128 + c8) = (f32x4){gf[0], gf[1], gf[2], gf[3]};
        *(LAS f32x4*)(gL + t * 128 + c8 + 4) = (f32x4){gf[4], gf[5], gf[6], gf[7]};
        const u32x4 vv = st.v[e];
#pragma unroll
        for (int j = 0; j < 4; ++j) { const int ts = t ^ ((id & 7) * 8); vT[(c8 + 2 * j) * 72 + ts] = (bf16_t)(vv[j] & 0xffffu); vT[(c8 + 2 * j + 1) * 72 + ts] = (bf16_t)(vv[j] >> 16); }
        if (WITH_Q) *(LAS u32x4*)((LAS bf16_t*)(lds + q_off) + t * 136 + c8) = st.q[e];
    }
    __syncthreads();
    {
        const int k = tid & 127, part = tid >> 7;
        float run = 0.f;
#pragma unroll
        for (int i = 0; i < 16; ++i) { const int t = part * 16 + i; run += gL[t * 128 + k]; bL[t * 128 + k] = run; }
        tot[part * 128 + k] = run;
    }
    __syncthreads();
}

DI void hgrn_local_phase(LAS unsigned char* lds, const bf16_t* U, bf16_t* DS, float* DEC, int wg, int nwg) {
    LAS float* gL = (LAS float*)(lds + HL_G); LAS float* bL = (LAS float*)(lds + HL_B); LAS float* tot = (LAS float*)(lds + HL_TOT);
    LAS bf16_t* vT = (LAS bf16_t*)(lds + H1_VT); LAS bf16_t* keT = (LAS bf16_t*)(lds + H1_KET);
    const int tid = otid(), lane = tid & 63, w = tid >> 6, fr = lane & 15, fq = lane >> 4;
    HStage st;
    if (wg < 2048) hgrn_load<false>(st, U, wg, tid);
    for (int it = wg; it < 2048; it += nwg) {
        hgrn_commit<false>(st, lds, H1_VT, 0, tid);
        if (it + nwg < 2048) hgrn_load<false>(st, U, it + nwg, tid);
        {
            const int k = tid & 127, sg = tid >> 7;
            const float t0 = tot[k], t1 = tot[128 + k], t2 = tot[256 + k], t3 = tot[384 + k];
            const float bend = (t0 + t1) + (t2 + t3);
            const float pre = sg == 0 ? 0.f : (sg == 1 ? t0 : (sg == 2 ? t0 + t1 : t0 + t1 + t2));
            unsigned pk[8];
#pragma unroll
            for (int i = 0; i < 16; i += 2) {
                const int s = sg * 16 + i;
                const float ke0 = (1.0f - __expf(gL[s * 128 + k])) * __expf(bend - (bL[s * 128 + k] + pre));
                const float ke1 = (1.0f - __expf(gL[(s + 1) * 128 + k])) * __expf(bend - (bL[(s + 1) * 128 + k] + pre));
                pk[i >> 1] = pk2(ke0, ke1);
            }
            *(LAS u32x4*)(keT + k * 72 + sg * 16) = (u32x4){pk[0], pk[1], pk[2], pk[3]};
            *(LAS u32x4*)(keT + k * 72 + sg * 16 + 8) = (u32x4){pk[4], pk[5], pk[6], pk[7]};
            if (sg == 0) DEC[(size_t)it * 128 + k] = __expf(bend);
        }
        __syncthreads();
        {
            bf16x8 a[2];
#pragma unroll
            for (int ks = 0; ks < 2; ++ks) a[ks] = *(const LAS bf16x8*)(keT + (16 * w + fr) * 72 + ks * 32 + 8 * fq);
#pragma unroll
            for (int vt = 0; vt < 8; ++vt) {
                f32x4 acc = {0.f, 0.f, 0.f, 0.f};
#pragma unroll
                for (int ks = 0; ks < 2; ++ks) { const bf16x8 bb = *(const LAS bf16x8*)(vT + (16 * vt + fr) * 72 + ((ks * 32 + 8 * fq) ^ (((2 * vt + (fr >> 3)) & 7) * 8))); acc = mfma16(a[ks], bb, acc); }
                u32x2 pkd = {pk2(acc[0], acc[1]), pk2(acc[2], acc[3])};
                *(u32x2*)(DS + (size_t)it * 16384 + (16 * vt + fr) * 128 + 16 * w + 4 * fq) = pkd;
            }
        }
        __syncthreads();
    }
}

DI void hgrn_scan_phase(LAS unsigned char* lds, const bf16_t* DS, const float* DEC, bf16_t* SIN, int wg, int nwg) {
    LAS float* dL = (LAS float*)lds;
    const int tid = otid();
    for (int slice = wg; slice < 256; slice += nwg) {
        const int gt = slice * 512 + tid, bh = gt >> 13, rem = gt & 8191, v = rem >> 6, k2 = (rem & 63) * 2;
        const size_t base = (size_t)bh * 128;
        f32x4 dv[8];
#pragma unroll
        for (int e = 0; e < 8; ++e) dv[e] = *(const f32x4*)(DEC + base * 128 + (size_t)(tid + 512 * e) * 4);
        __builtin_amdgcn_sched_barrier(0);
#pragma unroll
        for (int e = 0; e < 8; ++e) *(LAS f32x4*)(dL + (tid + 512 * e) * 4) = dv[e];
        __syncthreads();
        const bf16_t* dsp = DS + base * 16384 + v * 128 + k2; bf16_t* sp = SIN + base * 16384 + v * 128 + k2;
        f32x2 st = {0.f, 0.f};
        unsigned bA[16], bB[16];
#define SC_LOAD(buf, c0) do { _Pragma("unroll") for (int j = 0; j < 16; ++j) buf[j] = *(const unsigned*)(dsp + (size_t)((c0) + j) * 16384); } while (0)
#define SC_STEP(buf, c0) do { _Pragma("unroll") for (int j = 0; j < 16; ++j) { const f32x2 d2 = *(const LAS f32x2*)(dL + ((c0) + j) * 128 + k2); \
            *(unsigned*)(sp + (size_t)((c0) + j) * 16384) = pk2(st[0], st[1]); const f32x2 dl = {bf_lo(buf[j]), bf_hi(buf[j])}; st = d2 * st + dl; } } while (0)
        SC_LOAD(bA, 0);
#pragma unroll 1
        for (int c0 = 0; c0 < 128; c0 += 32) {
            SC_LOAD(bB, c0 + 16);
            SC_STEP(bA, c0);
            if (c0 + 32 < 128) SC_LOAD(bA, c0 + 32);
            SC_STEP(bB, c0 + 16);
        }
#undef SC_LOAD
#undef SC_STEP
        __syncthreads();
    }
}

DI void hgrn_out_phase(LAS unsigned char* lds, const bf16_t* U, const bf16_t* SIN, bf16_t* GA, const float* ng, int wg, int nwg) {
    LAS float* gL = (LAS float*)(lds + HL_G); LAS float* bL = (LAS float*)(lds + HL_B); LAS float* tot = (LAS float*)(lds + HL_TOT); LAS float* red = (LAS float*)(lds + HL_RED);
    LAS bf16_t* qeL = (LAS bf16_t*)(lds + H3_QE); LAS bf16_t* qmL = (LAS bf16_t*)(lds + H3_QM); LAS bf16_t* kmL = (LAS bf16_t*)(lds + H3_KM); LAS bf16_t* vT = (LAS bf16_t*)(lds + H3_VT);
    const int tid = otid(), lane = tid & 63, w = tid >> 6, fr = lane & 15, fq = lane >> 4;
    const int tt = w & 3, vh = w >> 2;
    HStage st;
    bf16x8 sA[4][4]; u32x2 gatev[4];
#define H3_LOAD_SA(item) do { const int _c = (item) & 127, _bh = (item) >> 7, _row0 = (_bh >> 3) * SEQ_ + _c * 64, _h = _bh & 7; \
        _Pragma("unroll") for (int vi = 0; vi < 4; ++vi) { const int v = 16 * (vh * 4 + vi) + fr; \
            _Pragma("unroll") for (int ks = 0; ks < 4; ++ks) sA[vi][ks] = *(const bf16x8*)(SIN + (size_t)(item) * 16384 + v * 128 + ks * 32 + 8 * fq); \
            gatev[vi] = *(const u32x2*)(U + us_off(_row0 + 16 * tt + fr, UC_AG + _h * 128 + 16 * (vh * 4 + vi) + 4 * fq)); } } while (0)
    if (wg < 2048) hgrn_load<true>(st, U, wg, tid);
    for (int it = wg; it < 2048; it += nwg) {
        const int c = it & 127, bh = it >> 7, b = bh >> 3, h = bh & 7, row0 = b * SEQ_ + c * 64;
        H3_LOAD_SA(it);
        hgrn_commit<true>(st, lds, H3_VT, H3_QE, tid);
        if (it + nwg < 2048) hgrn_load<true>(st, U, it + nwg, tid);
        {
            const int k = tid & 127, tg = tid >> 7;
            const float t0 = tot[k], t1 = tot[128 + k], t2 = tot[256 + k];
            const float pre = tg == 0 ? 0.f : (tg == 1 ? t0 : (tg == 2 ? t0 + t1 : t0 + t1 + t2));
            const float r = t0 + bL[31 * 128 + k];
#pragma unroll 4
            for (int i = 0; i < 16; ++i) {
                const int t = tg * 16 + i;
                const float bt = bL[t * 128 + k] + pre, gt = gL[t * 128 + k];
                const float qf = bf1(qeL[t * 136 + k]);
                qeL[t * 136 + k] = f2bf(qf * __expf(bt));
                qmL[t * 136 + k] = f2bf(qf * __expf(bt - r));
                kmL[t * 136 + k] = f2bf((1.0f - __expf(gt)) * __expf(r - bt));
            }
        }
        __syncthreads();
        f32x4 acc[4];
#pragma unroll
        for (int vi = 0; vi < 4; ++vi) acc[vi] = (f32x4){0.f, 0.f, 0.f, 0.f};
        {
            bf16x8 qmf[4];
#pragma unroll
            for (int ks = 0; ks < 4; ++ks) qmf[ks] = *(const LAS bf16x8*)(qmL + (16 * tt + fr) * 136 + ks * 32 + 8 * fq);
            f32x4 sc[4];
#pragma unroll
            for (int st = 0; st < 4; ++st) {
                sc[st] = (f32x4){0.f, 0.f, 0.f, 0.f};
                if (st <= tt) {
#pragma unroll
                    for (int ks = 0; ks < 4; ++ks) { const bf16x8 a = *(const LAS bf16x8*)(kmL + (16 * st + fr) * 136 + ks * 32 + 8 * fq); sc[st] = mfma16(a, qmf[ks], sc[st]); }
                    if (st == tt) {
#pragma unroll
                        for (int j = 0; j < 4; ++j) sc[st][j] = (4 * fq + j <= fr) ? sc[st][j] : 0.f;
                    }
                }
            }
#pragma unroll
            for (int p = 0; p < 2; ++p) {
                if (2 * p <= tt) {
                    const u32x4 pku = {pk2(sc[2 * p][0], sc[2 * p][1]), pk2(sc[2 * p][2], sc[2 * p][3]), pk2(sc[2 * p + 1][0], sc[2 * p + 1][1]), pk2(sc[2 * p + 1][2], sc[2 * p + 1][3])};
                    const bf16x8 P = __builtin_bit_cast(bf16x8, pku);
#pragma unroll
                    for (int vi = 0; vi < 4; ++vi) {
                        const int v = 16 * (vh * 4 + vi) + fr;
                        const int swr = ((2 * (vh * 4 + vi) + (fr >> 3)) & 7) * 8;
                        const u32x2 lo = *(const LAS u32x2*)(vT + v * 72 + ((32 * p + 4 * fq) ^ swr)), hi = *(const LAS u32x2*)(vT + v * 72 + ((32 * p + 16 + 4 * fq) ^ swr));
                        const u32x4 au = {lo[0], lo[1], hi[0], hi[1]};
                        acc[vi] = mfma16(__builtin_bit_cast(bf16x8, au), P, acc[vi]);
                    }
                }
            }
#pragma unroll
            for (int ks = 0; ks < 4; ++ks) {
                const bf16x8 bq = *(const LAS bf16x8*)(qeL + (16 * tt + fr) * 136 + ks * 32 + 8 * fq);
#pragma unroll
                for (int vi = 0; vi < 4; ++vi) {
                    acc[vi] = mfma16(sA[vi][ks], bq, acc[vi]);
                }
            }
        }
        float ss = 0.f;
#pragma unroll
        for (int vi = 0; vi < 4; ++vi) ss += (acc[vi][0] * acc[vi][0] + acc[vi][1] * acc[vi][1]) + (acc[vi][2] * acc[vi][2] + acc[vi][3] * acc[vi][3]);
        ss += __shfl_xor(ss, 16); ss += __shfl_xor(ss, 32);
        if (fq == 0) red[vh * 64 + 16 * tt + fr] = ss;
        __syncthreads();
        {
            const float tot2 = red[16 * tt + fr] + red[64 + 16 * tt + fr];
            const float rinv = rsqrtf(tot2 * (1.0f / 128.0f) + 1e-6f);
            const size_t trow = (size_t)(row0 + 16 * tt + fr);
            f32x4 g4v[4];
#pragma unroll
            for (int vi = 0; vi < 4; ++vi) g4v[vi] = *(const f32x4*)(ng + h * 128 + 16 * (vh * 4 + vi) + 4 * fq);
#pragma unroll
            for (int vi = 0; vi < 4; ++vi) {
                const int vb = h * 128 + 16 * (vh * 4 + vi) + 4 * fq;
                const f32x4 g4 = g4v[vi];
                const u32x2 gate = gatev[vi];
                const float o0 = acc[vi][0] * rinv * g4[0] * bf_lo(gate[0]), o1 = acc[vi][1] * rinv * g4[1] * bf_hi(gate[0]);
                const float o2 = acc[vi][2] * rinv * g4[2] * bf_lo(gate[1]), o3 = acc[vi][3] * rinv * g4[3] * bf_hi(gate[1]);
                u32x2 pk = {pk2(o0, o1), pk2(o2, o3)};
                *(u32x2*)(GA + trow * 1024 + vb) = pk;
            }
        }
        __syncthreads();
    }
#undef H3_LOAD_SA
}

constexpr int AT_K = 0, AT_VT = 256 * 72 * 2, AT_BIAS = AT_VT + 256 * 72 * 2;
DI void attn_phase(LAS unsigned char* lds, const bf16_t* U, bf16_t* GB, const float* BIAS, const float* sinks, int wg, int nwg) {
    LAS bf16_t* Kl = (LAS bf16_t*)(lds + AT_K); LAS bf16_t* Vt = (LAS bf16_t*)(lds + AT_VT); LAS float* biasL = (LAS float*)(lds + AT_BIAS);
    const int tid = otid(), lane = tid & 63, w = tid >> 6, fr = lane & 15, fq = lane >> 4;
    u32x4 pkv[4], pvv[4];
#define AT_LOAD_KV(item) do { const int _kvh = (item) & 3, _blk = ((item) >> 2) & 63, _b = (item) >> 8, _rc0 = _b * SEQ_ + _blk * 128, _rp0 = _blk > 0 ? _rc0 - 128 : _rc0; \
        _Pragma("unroll") for (int e = 0; e < 4; ++e) { const int id = tid + 512 * e, j = id >> 3, c8 = (id & 7) * 8; const int row = j < 128 ? _rp0 + j : _rc0 + j - 128; \
            pkv[e] = *(const u32x4*)(U + us_off(row, UC_BK + _kvh * 64 + c8)); pvv[e] = *(const u32x4*)(U + us_off(row, UC_BV + _kvh * 64 + c8)); } } while (0)
    if (wg < 512) AT_LOAD_KV(wg);
    for (int it = wg; it < 512; it += nwg) {
        const int kvh = it & 3, blk = (it >> 2) & 63, b = it >> 8;
        const int rc0 = b * SEQ_ + blk * 128;
        bf16x8 qn[2]; u32x2 gn[4];
#define AT_LOAD_Q(unit_) do { const int _g = (unit_) >> 3, _mt = (unit_) & 7, _hq = kvh * 4 + _g; const int _qrow = rc0 + 16 * _mt + fr; \
        _Pragma("unroll") for (int ks = 0; ks < 2; ++ks) qn[ks] = *(const bf16x8*)(U + us_off(_qrow, UC_BQ + _hq * 64 + ks * 32 + 8 * fq)); \
        _Pragma("unroll") for (int dt = 0; dt < 4; ++dt) gn[dt] = *(const u32x2*)(U + us_off(_qrow, UC_BG + _hq * 64 + 16 * dt + 4 * fq)); } while (0)
        const float bias_v = BIAS[(kvh * 4 + (tid >> 7)) * 128 + (tid & 127)];
        const float sk0 = sinks[kvh * 4 + 0], sk1 = sinks[kvh * 4 + 1], sk2 = sinks[kvh * 4 + 2], sk3 = sinks[kvh * 4 + 3];
        AT_LOAD_Q(w * 4);
#pragma unroll
        for (int e = 0; e < 4; ++e) {
            const int id = tid + 512 * e, j = id >> 3, c8 = (id & 7) * 8;
            *(LAS u32x4*)(Kl + j * 72 + c8) = pkv[e];
            *(LAS u32x4*)(Vt + j * 72 + c8) = pvv[e];
        }
        biasL[tid] = bias_v;
        __syncthreads();
        if (it + nwg < 512) AT_LOAD_KV(it + nwg);
#pragma unroll 1
        for (int e = 0; e < 4; ++e) {
            const int unit = w * 4 + e, g = unit >> 3, mt = unit & 7, hq = kvh * 4 + g;
            const size_t qrow = (size_t)(rc0 + 16 * mt + fr);
            bf16x8 qf[2]; u32x2 gcur[4];
#pragma unroll
            for (int ks = 0; ks < 2; ++ks) qf[ks] = qn[ks];
#pragma unroll
            for (int dt = 0; dt < 4; ++dt) gcur[dt] = gn[dt];
            if (e < 3) AT_LOAD_Q(unit + 1);
            f32x4 sc[9];
#pragma unroll
            for (int n = 0; n < 9; ++n) {
                sc[n] = (f32x4){0.f, 0.f, 0.f, 0.f};
#pragma unroll
                for (int ks = 0; ks < 2; ++ks) { const bf16x8 a = *(const LAS bf16x8*)(Kl + (16 * (mt + n) + fr) * 72 + ks * 32 + 8 * fq); sc[n] = mfma16(a, qf[ks], sc[n]); }
            }
            float mx = -INFINITY;
#pragma unroll
            for (int n = 0; n < 9; ++n)
#pragma unroll
                for (int j = 0; j < 4; ++j) {
                    const int rel = 128 + fr - 16 * n - 4 * fq - j, jidx = 16 * (mt + n) + 4 * fq + j;
                    const bool valid = (rel >= 0) && (rel <= 127) && (blk > 0 || jidx >= 128);
                    const int relc = rel < 0 ? 0 : (rel > 127 ? 127 : rel);
                    const float s = valid ? sc[n][j] + biasL[g * 128 + relc] : -INFINITY;
                    sc[n][j] = s; mx = fmaxf(mx, s);
                }
            mx = fmaxf(mx, __shfl_xor(mx, 16)); mx = fmaxf(mx, __shfl_xor(mx, 32));
            const float sink = g == 0 ? sk0 : (g == 1 ? sk1 : (g == 2 ? sk2 : sk3));
            const float mm = fmaxf(mx, sink);
            float lsum = 0.f;
#pragma unroll
            for (int n = 0; n < 9; ++n)
#pragma unroll
                for (int j = 0; j < 4; ++j) { const float pz = __expf(sc[n][j] - mm); sc[n][j] = pz; lsum += pz; }
            lsum += __shfl_xor(lsum, 16); lsum += __shfl_xor(lsum, 32);
            lsum += __expf(sink - mm);
            const float inv = 1.0f / lsum;
            f32x4 o[4];
#pragma unroll
            for (int dt = 0; dt < 4; ++dt) o[dt] = (f32x4){0.f, 0.f, 0.f, 0.f};
            {
                const unsigned vbase = (unsigned)(size_t)(Vt + (16 * mt + 4 * fq + (fr >> 2)) * 72 + 4 * (fr & 3));
#define AT_PV(q_, OA_, OB_) do { u32x2 lo[4], hi[4]; tr_read8<OA_, OB_>(vbase, lo, hi); \
                u32x4 pku; pku[0] = pk2(sc[2 * (q_)][0], sc[2 * (q_)][1]); pku[1] = pk2(sc[2 * (q_)][2], sc[2 * (q_)][3]); \
                if (2 * (q_) + 1 < 9) { pku[2] = pk2(sc[(2 * (q_) + 1) % 9][0], sc[(2 * (q_) + 1) % 9][1]); pku[3] = pk2(sc[(2 * (q_) + 1) % 9][2], sc[(2 * (q_) + 1) % 9][3]); } else { pku[2] = 0u; pku[3] = 0u; } \
                const bf16x8 P = __builtin_bit_cast(bf16x8, pku); \
                _Pragma("unroll") for (int dt = 0; dt < 4; ++dt) { const u32x4 au = {lo[dt][0], lo[dt][1], hi[dt][0], hi[dt][1]}; o[dt] = mfma16(__builtin_bit_cast(bf16x8, au), P, o[dt]); } } while (0)
                AT_PV(0, 0, 2304); AT_PV(1, 4608, 6912); AT_PV(2, 9216, 11520); AT_PV(3, 13824, 16128); AT_PV(4, 18432, 18432);
#undef AT_PV
            }
#pragma unroll
            for (int dt = 0; dt < 4; ++dt) {
                const int d0 = hq * 64 + 16 * dt + 4 * fq;
                const u32x2 gate = gcur[dt];
                const float o0 = o[dt][0] * inv * bf_lo(gate[0]), o1 = o[dt][1] * inv * bf_hi(gate[0]), o2 = o[dt][2] * inv * bf_lo(gate[1]), o3 = o[dt][3] * inv * bf_hi(gate[1]);
                u32x2 pk = {pk2(o0, o1), pk2(o2, o3)};
                *(u32x2*)(GB + qrow * 1024 + d0) = pk;
            }
        }
        __syncthreads();
    }
#undef AT_LOAD_KV
#undef AT_LOAD_Q
}

#define XB_TMO      128
#define XB_XCNT(j)  (256  + 64 * (j))
#define XB_XSUB(j)  (1280 + 64 * (j))
#define XB_XGEN(j)  (2304 + 64 * (j))
#define XB_TOP      3328
#define XB_TOPGEN   3392
#define XCD_BAR_WORDS 3456
#define XB_SPIN_CAP (1u << 18)

__device__ __forceinline__ unsigned xb_ld(unsigned* p)              { return __hip_atomic_load(p, __ATOMIC_RELAXED, __HIP_MEMORY_SCOPE_AGENT); }
__device__ __forceinline__ unsigned xb_add(unsigned* p, unsigned v) { return __hip_atomic_fetch_add(p, v, __ATOMIC_RELAXED, __HIP_MEMORY_SCOPE_AGENT); }
__device__ __forceinline__ unsigned xb_xcc_id() { return (unsigned)__builtin_amdgcn_s_getreg((3 << 11) | 20) & 0xFu; }
#define XB_SPIN(cond, bar) do { unsigned _sp = 0; while (cond) { __builtin_amdgcn_s_sleep(1); \
    if ((++_sp & 255u) == 0u) { if (xb_ld(&(bar)[XB_TMO])) break; if (_sp > XB_SPIN_CAP) { atomicAdd(&(bar)[XB_TMO], 1u); break; } } } } while (0)

struct XcdBarrier {
    unsigned* bar; unsigned x;
    volatile LAS unsigned* st;
};

__device__ __forceinline__ XcdBarrier xcd_barrier_post(unsigned* bar, volatile LAS unsigned* st) {
    XcdBarrier b; b.bar = bar; b.x = xb_xcc_id(); b.st = st;
    if (threadIdx.x == 0) (void)xb_add(&bar[XB_XCNT(b.x)], 1u);
    return b;
}
__device__ __forceinline__ void xcd_barrier_complete(unsigned* bar, unsigned x, unsigned& nloc, unsigned& nx) {
    const unsigned G = gridDim.x * gridDim.y * gridDim.z;
    unsigned sum, cnt, mine, sp = 0u;
    for (;;) {
        sum = 0u; cnt = 0u; mine = 0u;
#pragma unroll
        for (unsigned j = 0; j < 16; ++j) { const unsigned c = xb_ld(&bar[XB_XCNT(j)]); sum += c; cnt += (c > 0u) ? 1u : 0u; mine = (j == x) ? c : mine; }
        if (sum == G) break;
        __builtin_amdgcn_s_sleep(1);
        if ((++sp & 255u) == 0u) { if (xb_ld(&bar[XB_TMO])) break; if (sp > XB_SPIN_CAP) { atomicAdd(&bar[XB_TMO], 1u); break; } }
    }
    nloc = mine > 0u ? mine : 1u; nx = cnt > 0u ? cnt : 1u;
}

__device__ __forceinline__ void xcd_barrier(const XcdBarrier& b) {
    asm volatile("s_waitcnt vmcnt(0)" ::: "memory");
    __syncthreads();
    if (threadIdx.x == 0) {
        unsigned* bar = b.bar;
        __builtin_amdgcn_s_waitcnt(0);
        unsigned nloc = b.st[0], nx = b.st[1];
        if (nloc == 0u) { xcd_barrier_complete(bar, b.x, nloc, nx); b.st[0] = nloc; b.st[1] = nx; }
        const unsigned old = xb_add(&bar[XB_XSUB(b.x)], 1u);
        const unsigned gen = old / nloc;
        if (old + 1u == (gen + 1u) * nloc) {
            __builtin_amdgcn_fence(__ATOMIC_RELEASE, "agent");
            asm volatile("s_waitcnt vmcnt(0)" ::: "memory");
            const unsigned og = xb_add(&bar[XB_TOP], 1u);
            const unsigned tg = og / nx;
            if (og + 1u == (tg + 1u) * nx) xb_add(&bar[XB_TOPGEN], 1u);
            else XB_SPIN(xb_ld(&bar[XB_TOPGEN]) == tg, bar);
            __builtin_amdgcn_fence(__ATOMIC_ACQUIRE, "agent");
            xb_add(&bar[XB_XGEN(b.x)], 1u);
            asm volatile("s_waitcnt vmcnt(0)" ::: "memory");
        } else {
            XB_SPIN(xb_ld(&bar[XB_XGEN(b.x)]) == gen, bar);
            __builtin_amdgcn_fence(__ATOMIC_ACQUIRE, "agent");
            asm volatile("s_waitcnt vmcnt(0)" ::: "memory");
        }
    }
    __syncthreads();
}


DI void stagger(int wg, int S, unsigned ticks) {
    const unsigned grp = (unsigned)(wg >> 3) % (unsigned)S;
    if (grp) { const unsigned long long t0 = __builtin_amdgcn_s_memrealtime(), d = (unsigned long long)grp * ticks; while (__builtin_amdgcn_s_memrealtime() - t0 < d) __builtin_amdgcn_s_sleep(16); }
}
__global__ void __launch_bounds__(512, 2) mega_fwd(Params p) {
    extern __shared__ __attribute__((aligned(16))) unsigned char smem[];
    LAS unsigned char* lds = (LAS unsigned char*)smem;
    cg::grid_group grid = cg::this_grid();
    const int wg = blockIdx.x, nwg = gridDim.x, tid = otid();
    unsigned char* ws = p.ws;
    LAS unsigned* stw = (LAS unsigned*)(lds + LDS_BYTES - 16);
    if (tid < 4) stw[tid] = 0u;
    __syncthreads();
    const XcdBarrier bar = xcd_barrier_post((unsigned*)(ws + WS_BAR), (volatile LAS unsigned*)stw);
#define GSYNC() xcd_barrier(bar)
    bf16_t* WIN = (bf16_t*)(ws + WS_WIN); bf16_t* WPA = (bf16_t*)(ws + WS_WPA); bf16_t* WPB = (bf16_t*)(ws + WS_WPB); bf16_t* WPC = (bf16_t*)(ws + WS_WPC); bf16_t* WOUT = (bf16_t*)(ws + WS_WOUT);
    bf16_t* U = (bf16_t*)(ws + WS_U); bf16_t* US = (bf16_t*)(ws + WS_US); float* X = (float*)(ws + WS_X); bf16_t* XB = (bf16_t*)(ws + WS_XB);
    bf16_t* GA = (bf16_t*)(ws + WS_GA); bf16_t* GB = (bf16_t*)(ws + WS_GB); bf16_t* GC = (bf16_t*)(ws + WS_GC); bf16_t* MG = (bf16_t*)(ws + WS_MG);
    bf16_t* DS = (bf16_t*)(ws + WS_DS); bf16_t* SIN = (bf16_t*)(ws + WS_SIN); float* DEC = (float*)(ws + WS_DEC); float* LB = (float*)(ws + WS_LB); float* BIAS = (float*)(ws + WS_BIAS);

#pragma unroll 1
    for (int rep = 0; rep < REP_PRO; ++rep) {
    for (size_t i = (size_t)wg * 512 + tid; i < (size_t)M_ * D_ / 4; i += (size_t)nwg * 512) {
        const f32x4 v = *(const f32x4*)(p.x + i * 4);
        u32x2 pk = {pk2(v[0], v[1]), pk2(v[2], v[3])};
        *(u32x2*)(XB + i * 4) = pk;
    }
    {
        const int gt = wg * 512 + tid;
        if (gt < 1024) {
            const float a0 = p.lb_param[gt], a1 = p.lb_param[1024 + gt], a2 = p.lb_param[2048 + gt], a3 = p.lb_param[3072 + gt];
            const float mx = fmaxf(fmaxf(a0, a1), fmaxf(a2, a3));
            const float e0 = expf(a0 - mx), e1 = expf(a1 - mx), e2 = expf(a2 - mx), e3 = expf(a3 - mx);
            const float inv = 1.0f / (e0 + e1 + e2 + e3);
            LB[gt] = 0.f; LB[1024 + gt] = e1 * inv; LB[2048 + gt] = (e1 + e2) * inv; LB[3072 + gt] = (e1 + e2 + e3) * inv;
        } else if (gt < 1024 + 2048) {
            const int hh = (gt - 1024) >> 7, rel = (gt - 1024) & 127;
            int bucket = rel;
            if (rel >= 16) { const float logd = logf((float)rel / 16.0f) / logf(8.0f); int lg = 16 + (int)(logd * 16.0f); bucket = lg > 31 ? 31 : lg; }
            BIAS[hh * 128 + rel] = p.rel_bias[bucket * 16 + hh];
        }
    }
#pragma unroll 1
    for (int l = 0; l < DEPTH_; ++l) convert_layer_weights(lds, p, ws, l, wg, nwg, (HIDE_CVT && l > 0) ? 2 : 0);
    }
    if (p.out == nullptr) grid.sync();
    GSYNC();

    unsigned long long tacc = 0ull, tq0 = 0ull;
#define TQ_BEGIN(id) do { if (PROBE_ID == (id)) tq0 = __builtin_amdgcn_s_memrealtime(); } while (0)
#define TQ_END(id) do { if (PROBE_ID == (id)) tacc += __builtin_amdgcn_s_memrealtime() - tq0; } while (0)
#pragma unroll 1
    for (int l = 0; l < DEPTH_; ++l) {
#pragma unroll 1
        for (int rep = 0; rep < REP_GIN; ++rep) {
            stagger(wg, STG_IN_S, STG_IN_T);
            pg8::Gemm g; g.A = XB; g.Bt = WIN + (size_t)l * NIN_ * D_; g.M = M_; g.N = NIN_; g.K = D_;
            pg8::StaticOrder S; S.init(M_, NIN_, nwg, wg);
            EpiIn E; E.U = U; E.lb = LB + l * 1024; E.GT = (bf16_t*)(ws + WS_GT); E.US = (bf16_t*)(ws + WS_US);
            pg8::gemm_phase<EpiIn, pg8::StaticOrder, false>(lds, g, S, E, nullptr);
            if (HIDE_CVT && rep == 0 && l + 1 < DEPTH_) {
                const int rem = ((M_ / 256) * (NIN_ / 256)) % nwg;
                const int tw = rem == 0 ? wg : wg - rem, tn = rem == 0 ? nwg : nwg - rem;
                if (tw >= 0) convert_layer_weights(lds, p, ws, l + 1, tw, tn, 1);
            }
        }
        GSYNC();
        TQ_BEGIN(1); TQ_BEGIN(2);
#pragma unroll 1
        for (int rep = 0; rep < REP_P2; ++rep) {
        hgrn_local_phase(lds, US, DS, DEC, wg, nwg);
        TQ_END(2); TQ_BEGIN(3);
        attn_phase(lds, US, GB, BIAS, p.sinks + l * 16, wg, nwg);
        TQ_END(3); TQ_BEGIN(4);
        conv_phase(U, U + (size_t)M_ * 1024, GC, p.conv_w + (size_t)l * 3 * 1024, wg, nwg);
        TQ_END(4);
        }
        GSYNC();
        TQ_END(1); TQ_BEGIN(5);
#pragma unroll 1
        for (int rep = 0; rep < REP_SCAN; ++rep)
        hgrn_scan_phase(lds, DS, DEC, SIN, wg, nwg);
        GSYNC();
        TQ_END(5); TQ_BEGIN(6);
#pragma unroll 1
        for (int rep = 0; rep < REP_H3; ++rep)
        hgrn_out_phase(lds, US, SIN, GA, p.norm_g + l * 1024, wg, nwg);
        GSYNC();
        TQ_END(6);
        stagger(wg, STG_MG_S, STG_MG_T);
#pragma unroll 1
        for (int br = 0; br < 3 * REP_MG; ++br) {
            pg8::Gemm g; const int bq = br % 3; g.A = bq == 0 ? GA : (bq == 1 ? GB : GC); g.Bt = (bq == 0 ? WPA : (bq == 1 ? WPB : WPC)) + (size_t)l * D_ * 1024; g.M = M_; g.N = D_; g.K = 1024;
            pg8::StaticOrder S; S.init(M_, D_, nwg, wg);
            EpiMerge E; E.GTb = (const unsigned char*)(ws + WS_GT) + (size_t)bq * 512 * 65536; E.MP = (bf16_t*)(ws + WS_MP); E.Mg = MG; E.br = bq;
            pg8::gemm_phase<EpiMerge, pg8::StaticOrder, false>(lds, g, S, E, nullptr);
        }
        GSYNC();
        {
            pg8::Gemm g; g.A = MG; g.Bt = WOUT + (size_t)l * D_ * D_; g.M = M_; g.N = D_; g.K = D_;
            pg8::StaticOrder S; S.init(M_, D_, nwg, wg);
            EpiOut E; E.Y = GA;
            pg8::gemm_phase<EpiOut, pg8::StaticOrder, false>(lds, g, S, E, nullptr);
        }
        GSYNC();
        if (l == 0) ln_phase<true, false>(p.x, GA, p.out, XB, (unsigned char*)X, p.ln_g + l * D_, p.ln_b + l * D_, wg, nwg);
        else if (l == DEPTH_ - 1) ln_phase<false, true>(p.x, GA, p.out, XB, (unsigned char*)X, p.ln_g + l * D_, p.ln_b + l * D_, wg, nwg);
        else ln_phase<false, false>(p.x, GA, p.out, XB, (unsigned char*)X, p.ln_g + l * D_, p.ln_b + l * D_, wg, nwg);
        if (l != DEPTH_ - 1) GSYNC();
#pragma unroll 1
        for (int rep = 0; rep < REP_SYNC; ++rep) GSYNC();
    }
    if (PROBE_ID != 0) { GSYNC(); const unsigned long long t0 = __builtin_amdgcn_s_memrealtime(), d = tacc * PROBE_AMP; while (__builtin_amdgcn_s_memrealtime() - t0 < d) __builtin_amdgcn_s_sleep(32); }
}

extern "C" void kernel_launch(void* const* d_in, const int* in_sizes, int n_in, void* d_out, int out_size, void* d_ws, size_t ws_size, hipStream_t stream) {
    static int grid_blocks = 0;
    if (grid_blocks == 0) {
        if (n_in != 13 || out_size != M_ * D_ || ws_size < WS_END) { fprintf(stderr, "kernel_launch: unexpected shapes (n_in %d out %d ws %zu need %zu)\n", n_in, out_size, ws_size, (size_t)WS_END); grid_blocks = -1; return; }
        int dev = 0, cus = 0, per_cu = 0;
        hipGetDevice(&dev);
        hipDeviceGetAttribute(&cus, hipDeviceAttributeMultiprocessorCount, dev);
        if (hipFuncSetAttribute((const void*)mega_fwd, hipFuncAttributeMaxDynamicSharedMemorySize, LDS_BYTES) != hipSuccess) { fprintf(stderr, "kernel_launch: hipFuncSetAttribute failed\n"); grid_blocks = -1; return; }
        if (hipOccupancyMaxActiveBlocksPerMultiprocessor(&per_cu, (const void*)mega_fwd, 512, LDS_BYTES) != hipSuccess || per_cu < 1) { fprintf(stderr, "kernel_launch: occupancy query gave %d\n", per_cu); per_cu = 1; }
        (void)hipGetLastError();
        grid_blocks = cus * per_cu;
    }
    if (grid_blocks < 0) return;
    Params p{};
    p.x = (const float*)d_in[0]; p.w_in = (const float*)d_in[1]; p.w_pa = (const float*)d_in[2]; p.w_pb = (const float*)d_in[3]; p.w_pc = (const float*)d_in[4];
    p.w_out = (const float*)d_in[5]; p.lb_param = (const float*)d_in[6]; p.norm_g = (const float*)d_in[7]; p.sinks = (const float*)d_in[8]; p.conv_w = (const float*)d_in[9];
    p.rel_bias = (const float*)d_in[10]; p.ln_g = (const float*)d_in[11]; p.ln_b = (const float*)d_in[12];
    p.out = (float*)d_out; p.ws = (unsigned char*)d_ws;
    if (hipMemsetAsync((unsigned char*)d_ws + WS_BAR, 0, 16384, stream) != hipSuccess) { fprintf(stderr, "kernel_launch: memset of barrier words failed\n"); return; }
    void* args[] = {&p};
    hipError_t e = hipLaunchCooperativeKernel((const void*)mega_fwd, dim3(grid_blocks), dim3(512), args, LDS_BYTES, stream);
    if (e != hipSuccess) fprintf(stderr, "cooperative launch failed: %s (grid %d)\n", hipGetErrorString(e), grid_blocks);
}
```

```cpp
#include <hip/hip_runtime.h>
#include <hip/hip_cooperative_groups.h>
#include <cstdio>
namespace cg = cooperative_groups;
__device__ __forceinline__ int otid() { int t = threadIdx.x; asm volatile("" : "+v"(t)); return t; }
#ifndef REP_PRO
#define REP_PRO 1
#define REP_GIN 1
#define REP_P2 1
#define REP_SCAN 1
#define REP_H3 1
#endif
#define MRG_B 4
#define OUT_B 2
#ifndef REP_SYNC
#define REP_SYNC 0
#endif
#define STG_IN_S 1
#define STG_IN_T 900
#define STG_MG_S 1
#define STG_MG_T 1500
#ifndef REP_MG
#define REP_MG 1
#endif
#ifndef REP_OUT
#define REP_OUT 1
#define REP_LN 1
#endif
#ifndef PROBE_ID
#define PROBE_ID 0
#define PROBE_AMP 4
#endif
#ifndef HIDE_CVT
#define HIDE_CVT 1
#endif
namespace pg8 {
#define PG8_LAS __attribute__((address_space(3)))
typedef unsigned short bf16_t;
typedef short bf16x8 __attribute__((ext_vector_type(8)));
typedef float f32x4 __attribute__((ext_vector_type(4)));
typedef unsigned u32x4 __attribute__((ext_vector_type(4)));
constexpr int BM = 256, BK = 64, HALF = 128, HTB = HALF * BK * 2  , STAGE_BYTES = 8 * HTB, NXCD = 8, WGM = 8;

__host__ __device__ __forceinline__ int lds_byte(int r, int c) { const int st = (r >> 4) * 2 + (c >> 5), rr = r & 15, cc = c & 31, ob = rr * 64 + cc * 2; return st * 1024 + (ob ^ (((ob >> 9) & 1) << 5)); }
__host__ __device__ __forceinline__ void stage_rc(int b, int& R, int& C) { const int st = b / 1024, sb = b % 1024, swz = sb ^ (((sb >> 9) & 1) << 5); R = (st >> 1) * 16 + swz / 64; C = (st & 1) * 32 + (swz % 64) / 2; }
__host__ __device__ __forceinline__ int perm32(int rho) { const int n = rho >> 4, i = rho & 15; return 8 * (i >> 2) + 4 * n + (i & 3); }

struct Unit { int pm, pn; };
struct Gemm { const bf16_t* A; const bf16_t* Bt; int M, N, K; };

struct StaticOrder {
    int nM, nN, nwg, G, c;
    __host__ __device__ void init(int M, int N, int G_, int c_) { nM = M / BM; nN = N / BM; nwg = nM * nN; G = G_; c = c_; }
    __host__ __device__ bool next(int i, Unit& u) const {
        const long L = (long)i * G + c; if (L >= nwg) return false;
        int wgid = (int)L; { const int q = nwg / NXCD, r = nwg % NXCD, xcd = wgid % NXCD, off = wgid / NXCD; wgid = (xcd < r ? xcd * (q + 1) : r * (q + 1) + (xcd - r) * q) + off; }
        const int nig = WGM * nN, gid = wgid / nig, fm = gid * WGM, gsz = (nM - fm) < WGM ? (nM - fm) : WGM;
        u.pm = fm + ((wgid % nig) % gsz); u.pn = (wgid % nig) / gsz; return true;
    }
    __device__ __forceinline__ void a_ready(const Unit&) const {}
    __device__ __forceinline__ void done(const Unit&) const {}
};

template <class Epi, class Sched, bool STAMP = false>
__device__ __forceinline__ void gemm_phase(PG8_LAS unsigned char* lds, const Gemm g, const Sched& S, const Epi& E, unsigned long long* stamps) {
    const int tid = otid(), wid = __builtin_amdgcn_readfirstlane(tid >> 6), lane = tid & 63, wr = wid >> 2, wc = wid & 3, fr = lane & 15, fq = lane >> 4;
    const int K = g.K, nt = K / BK;
    int ts_lo = 0, ts_hi = 0, nts = 0; const unsigned long long rt_entry = STAMP ? (unsigned long long)wall_clock64() : 0ull;
#define PG8_STAMP() do { if (STAMP && wid == 0 && nts < 64) { const unsigned long long _c = (unsigned long long)clock64(); \
        ts_lo = (lane == nts) ? (int)(unsigned)_c : ts_lo; ts_hi = (lane == nts) ? (int)(unsigned)(_c >> 32) : ts_hi; ++nts; } } while (0)
    PG8_STAMP();
    unsigned voffA[2], voffB[2];
#pragma unroll
    for (int i = 0; i < 2; ++i) { int R, C; stage_rc(tid * 16 + i * 8192, R, C); const int Rb = Epi::PERM ? ((R & ~31) + perm32(R & 31)) : R;
        voffA[i] = (unsigned)(R * K + C) * 2u; voffB[i] = (unsigned)(Rb * K + C) * 2u; }
    const size_t kstep = (size_t)(BK * 2);
    const size_t hstep = (size_t)HALF * K * 2;
    const size_t tstep = 2 * hstep;
    const unsigned ldsw = (unsigned)wid * 1024u;
    const int aoff = lds_byte(wr * 64 + fr, fq * 8), boff = lds_byte(wc * 32 + fr, fq * 8);
#define PG8_SA(b, h) (((b) * 2 + (h)) * HTB)
#define PG8_SB(b, h) ((4 + (b) * 2 + (h)) * HTB)
#define PG8_STAGE(bufoff, gbase, voff) do { _Pragma("unroll") for (int _i = 0; _i < 2; ++_i) \
        __builtin_amdgcn_global_load_lds((const unsigned*)((const char*)(gbase) + (voff)[_i]), (PG8_LAS unsigned*)(lds + (bufoff) + ldsw + _i * 8192), 16, 0, 0); } while (0)
#define PG8_LDA(dst, b, h) do { _Pragma("unroll") for (int m = 0; m < 4; ++m) _Pragma("unroll") for (int k = 0; k < 2; ++k) dst[m][k] = *(const PG8_LAS bf16x8*)(lds + PG8_SA(b, h) + aoff + m * 2048 + k * 1024); } while (0)
#define PG8_LDB(dst, b, h) do { _Pragma("unroll") for (int n = 0; n < 2; ++n) _Pragma("unroll") for (int k = 0; k < 2; ++k) dst[n][k] = *(const PG8_LAS bf16x8*)(lds + PG8_SB(b, h) + boff + n * 2048 + k * 1024); } while (0)
#define PG8_MMA(ai, bj, At, Bt) do { __builtin_amdgcn_s_setprio(1); _Pragma("unroll") for (int m = 0; m < 4; ++m) _Pragma("unroll") for (int n = 0; n < 2; ++n) _Pragma("unroll") for (int k = 0; k < 2; ++k) \
        acc[ai][bj][m][n] = __builtin_amdgcn_mfma_f32_16x16x32_bf16(Bt[n][k], At[m][k], acc[ai][bj][m][n], 0, 0, 0); __builtin_amdgcn_s_setprio(0); } while (0)
#define PG8_WAIT_V(n) asm volatile("s_waitcnt vmcnt(" #n ")" ::: "memory")
#define PG8_WAIT_L(n) asm volatile("s_waitcnt lgkmcnt(" #n ")" ::: "memory")
#define PG8_BAR __builtin_amdgcn_s_barrier()
#define PG8_SCHED __builtin_amdgcn_sched_barrier(0)
    Unit cur, nxt; int ui = 0;
    if (!S.next(0, cur)) return;
    f32x4 acc[2][2][4][2];
#pragma unroll
    for (int a = 0; a < 2; ++a)
#pragma unroll
        for (int b = 0; b < 2; ++b)
#pragma unroll
            for (int m = 0; m < 4; ++m)
#pragma unroll
                for (int n = 0; n < 2; ++n) acc[a][b][m][n] = (f32x4){0.f, 0.f, 0.f, 0.f};
    bf16x8 At[4][2], B0[2][2], B1[2][2];
    const char* cA = (const char*)g.A + (size_t)cur.pm * tstep; const char* cB = (const char*)g.Bt + (size_t)cur.pn * tstep;
    S.a_ready(cur);
    PG8_STAGE(PG8_SB(0, 0), cB, voffB); PG8_STAGE(PG8_SA(0, 0), cA, voffA); PG8_STAGE(PG8_SB(0, 1), cB + hstep, voffB); PG8_STAGE(PG8_SA(0, 1), cA + hstep, voffA);
    if (wr == 1) PG8_BAR;
    PG8_WAIT_V(4); PG8_BAR;
    PG8_STAGE(PG8_SB(1, 0), cB + kstep, voffB); PG8_STAGE(PG8_SA(1, 0), cA + kstep, voffA); PG8_STAGE(PG8_SB(1, 1), cB + hstep + kstep, voffB);
    PG8_WAIT_V(6); PG8_BAR;
    PG8_STAMP();
    for (;;) {
        const bool has_next = S.next(ui + 1, nxt);
        const char* nA = has_next ? (const char*)g.A + (size_t)nxt.pm * tstep : cA; const char* nB = has_next ? (const char*)g.Bt + (size_t)nxt.pn * tstep : cB;
        for (int t = 0; t < nt; t += 2) {
            const bool last = (t == nt - 2);
            const char* a1 = cA + (size_t)(t + 1) * kstep;
            const char* a2 = last ? nA : cA + (size_t)(t + 2) * kstep; const char* b2 = last ? nB : cB + (size_t)(t + 2) * kstep;
            const char* a3 = a2 + kstep; const char* b3 = b2 + kstep;
            if (last && has_next) S.a_ready(nxt);
            PG8_LDB(B0, 0, 0); PG8_SCHED; PG8_LDA(At, 0, 0); PG8_STAGE(PG8_SA(1, 1), a1 + hstep, voffA);
            PG8_WAIT_L(8); PG8_BAR; PG8_WAIT_L(0); PG8_MMA(0, 0, At, B0); PG8_BAR; PG8_SCHED;
            PG8_LDB(B1, 0, 1); PG8_STAGE(PG8_SB(0, 0), b2, voffB);
            PG8_BAR; PG8_WAIT_L(0); PG8_MMA(0, 1, At, B1); PG8_BAR;
            PG8_LDA(At, 0, 1); PG8_STAGE(PG8_SA(0, 0), a2, voffA);
            PG8_BAR; PG8_WAIT_L(0); PG8_MMA(1, 0, At, B0); PG8_BAR; PG8_SCHED;
            PG8_STAGE(PG8_SB(0, 1), b2 + hstep, voffB);
            PG8_WAIT_V(6); PG8_BAR; PG8_MMA(1, 1, At, B1); PG8_BAR;
            PG8_LDB(B0, 1, 0); PG8_SCHED; PG8_LDA(At, 1, 0); PG8_STAGE(PG8_SA(0, 1), a2 + hstep, voffA);
            PG8_WAIT_L(8); PG8_BAR; PG8_WAIT_L(0); PG8_MMA(0, 0, At, B0); PG8_BAR; PG8_SCHED;
            PG8_LDB(B1, 1, 1); PG8_STAGE(PG8_SB(1, 0), b3, voffB);
            PG8_BAR; PG8_WAIT_L(0); PG8_MMA(0, 1, At, B1); PG8_BAR;
            PG8_LDA(At, 1, 1); PG8_STAGE(PG8_SA(1, 0), a3, voffA);
            PG8_BAR; PG8_WAIT_L(0); PG8_MMA(1, 0, At, B0); PG8_BAR; PG8_SCHED;
            PG8_STAGE(PG8_SB(1, 1), b3 + hstep, voffB);
            PG8_WAIT_V(6); PG8_BAR; PG8_MMA(1, 1, At, B1); PG8_BAR;
        }
        PG8_STAMP();
        if constexpr (!Epi::AFTER_DRAIN) { E(acc, cur, wr, wc, fr, fq); S.done(cur); }
        PG8_STAMP();
        if (!has_next) break;
#pragma unroll
        for (int a = 0; a < 2; ++a)
#pragma unroll
            for (int b = 0; b < 2; ++b)
#pragma unroll
                for (int m = 0; m < 4; ++m)
#pragma unroll
                    for (int n = 0; n < 2; ++n) acc[a][b][m][n] = (f32x4){0.f, 0.f, 0.f, 0.f};
        cur = nxt; cA = nA; cB = nB; ++ui;
    }
    PG8_WAIT_V(0);
    if (wr == 0) PG8_BAR;
    PG8_BAR;
    if constexpr (Epi::AFTER_DRAIN) { E.fused(acc, cur, wr, wc, fr, fq, lds, wid, lane); S.done(cur); }
    PG8_STAMP();
    if (STAMP && wid == 0) { stamps[lane] = lane < nts ? (((unsigned long long)(unsigned)ts_hi << 32) | (unsigned)ts_lo) : 0ull;
        if (lane == 62) stamps[62] = rt_entry; if (lane == 63) stamps[63] = (unsigned long long)wall_clock64(); }
#undef PG8_STAMP
#undef PG8_SA
#undef PG8_SB
#undef PG8_STAGE
#undef PG8_LDA
#undef PG8_LDB
#undef PG8_MMA
#undef PG8_WAIT_V
#undef PG8_WAIT_L
#undef PG8_BAR
#undef PG8_SCHED
}
}

#define LAS __attribute__((address_space(3)))
#define DI __device__ __forceinline__
using pg8::bf16_t; using pg8::bf16x8; using pg8::f32x4; using pg8::u32x4;
typedef float f32x2 __attribute__((ext_vector_type(2)));
typedef unsigned u32x2 __attribute__((ext_vector_type(2)));
typedef short s16x4 __attribute__((ext_vector_type(4)));
typedef __bf16 bf2_t __attribute__((ext_vector_type(2)));

constexpr int D_ = 2048, SEQ_ = 8192, M_ = 16384, DEPTH_ = 4, NIN_ = 16896;
constexpr int UC_AQ = 0, UC_AF = 1024, UC_AI = 2048, UC_AG = 3072, UC_BQ = 4096, UC_BK = 5120, UC_BV = 5376, UC_BG = 5632,
              UC_CB = 6656, UC_CC = 7680, UC_CX = 8704, UC_CG = 9728, UC_MA = 10752;
constexpr float ALPHA_ = 1.681792830507429f;
constexpr int LDS_BYTES = 147456;

constexpr size_t SZ_WIN = (size_t)DEPTH_ * NIN_ * D_ * 2, SZ_WP = (size_t)DEPTH_ * 2048 * 1024 * 2, SZ_WOUT = (size_t)DEPTH_ * 2048 * 2048 * 2;
constexpr size_t WS_WIN = 0, WS_WPA = WS_WIN + SZ_WIN, WS_WPB = WS_WPA + SZ_WP, WS_WPC = WS_WPB + SZ_WP, WS_WOUT = WS_WPC + SZ_WP;
constexpr size_t WS_U = WS_WOUT + SZ_WOUT, WS_X = WS_U + (size_t)M_ * NIN_ * 2, WS_XB = WS_X + (size_t)M_ * D_ * 4, WS_GA = WS_XB + (size_t)M_ * D_ * 2;
constexpr size_t WS_GB = WS_GA + (size_t)M_ * 1024 * 2, WS_GC = WS_GB + (size_t)M_ * 1024 * 2, WS_MG = WS_GC + (size_t)M_ * 1024 * 2;
constexpr size_t WS_DS = WS_MG + (size_t)M_ * D_ * 2, WS_SIN = WS_DS + (size_t)2048 * 16384 * 4, WS_DEC = WS_SIN + (size_t)2048 * 16384 * 2;
constexpr size_t WS_LB = WS_DEC + (size_t)2048 * 128 * 4, WS_BIAS = WS_LB + 4 * 1024 * 4, WS_BAR = WS_BIAS + 16 * 128 * 4, WS_GT = WS_BAR + 16384, WS_MP = WS_GT + (size_t)3 * 512 * 65536 * 2, WS_US = WS_MP + (size_t)512 * 65536 * 2, WS_END = WS_US + (size_t)208 * M_ * 64;

struct Params {
    const float* x; const float* w_in; const float* w_pa; const float* w_pb; const float* w_pc; const float* w_out; const float* lb_param;
    const float* norm_g; const float* sinks; const float* conv_w; const float* rel_bias; const float* ln_g; const float* ln_b;
    float* out; unsigned char* ws;
};

DI float bf_lo(unsigned u) { return __uint_as_float(u << 16); }
DI float bf_hi(unsigned u) { return __uint_as_float(u & 0xffff0000u); }
DI float bf1(bf16_t h) { return __uint_as_float(((unsigned)h) << 16); }
DI unsigned pk2(float lo, float hi) { f32x2 v = {lo, hi}; return __builtin_bit_cast(unsigned, __builtin_convertvector(v, bf2_t)); }
DI bf16_t f2bf(float x) { return (bf16_t)(pk2(x, 0.f) & 0xffffu); }
DI float fsigmoid(float x) { return __builtin_amdgcn_rcpf(1.0f + __expf(-x)); }
DI void unpack8(const u32x4 v, float (&o)[8]) {
    o[0] = bf_lo(v[0]); o[1] = bf_hi(v[0]); o[2] = bf_lo(v[1]); o[3] = bf_hi(v[1]); o[4] = bf_lo(v[2]); o[5] = bf_hi(v[2]); o[6] = bf_lo(v[3]); o[7] = bf_hi(v[3]);
}
DI size_t us_off(int row, int col) { return ((size_t)(col >> 5) * M_ + (size_t)row) * 32 + (size_t)(col & 31); }
DI void st_nt(u32x4* p, u32x4 v) { __builtin_nontemporal_store(v, p); }
DI void st_nt(u32x2* p, u32x2 v) { __builtin_nontemporal_store(v, p); }
DI u32x4 ld_nt(const u32x4* p) { return __builtin_nontemporal_load(p); }
DI u32x2 ld_nt(const u32x2* p) { return __builtin_nontemporal_load(p); }
template <int OA, int OB> DI void tr_read8(unsigned base, u32x2 (&lo)[4], u32x2 (&hi)[4]) {
    asm volatile("ds_read_b64_tr_b16 %0, %8 offset:%9\n\tds_read_b64_tr_b16 %1, %8 offset:%10\n\tds_read_b64_tr_b16 %2, %8 offset:%11\n\tds_read_b64_tr_b16 %3, %8 offset:%12\n\t"
                 "ds_read_b64_tr_b16 %4, %8 offset:%13\n\tds_read_b64_tr_b16 %5, %8 offset:%14\n\tds_read_b64_tr_b16 %6, %8 offset:%15\n\tds_read_b64_tr_b16 %7, %8 offset:%16\n\ts_waitcnt lgkmcnt(0)"
                 : "=&v"(lo[0]), "=&v"(lo[1]), "=&v"(lo[2]), "=&v"(lo[3]), "=&v"(hi[0]), "=&v"(hi[1]), "=&v"(hi[2]), "=&v"(hi[3])
                 : "v"(base), "n"(OA), "n"(OA + 32), "n"(OA + 64), "n"(OA + 96), "n"(OB), "n"(OB + 32), "n"(OB + 64), "n"(OB + 96)
                 : "memory");
}
DI f32x4 mfma16(bf16x8 a, bf16x8 b, f32x4 c) { return __builtin_amdgcn_mfma_f32_16x16x32_bf16(a, b, c, 0, 0, 0); }

struct EpiIn {
    static constexpr bool PERM = true, AFTER_DRAIN = false;
    bf16_t* U; const float* lb; bf16_t* GT; bf16_t* US;
    template <int MODE> DI void run(const f32x4 (&acc)[2][2][4][2], const pg8::Unit& u, int wr, int wc, int fr, int fq, float scale) const {
        const bool strip = u.pn < 26;
        const int row0 = u.pm * 256 + wr * 64 + fr, col0 = u.pn * 256 + wc * 32 + 8 * fq;
        f32x4 l0[2], l1[2];
#pragma unroll
        for (int bj = 0; bj < 2; ++bj) {
            if (MODE == 3) { l0[bj] = *(const f32x4*)(lb + (col0 - UC_AF) + bj * 128); l1[bj] = *(const f32x4*)(lb + (col0 - UC_AF) + bj * 128 + 4); }
            else { l0[bj] = (f32x4){0.f, 0.f, 0.f, 0.f}; l1[bj] = l0[bj]; }
        }
#pragma unroll
        for (int ai = 0; ai < 2; ++ai)
#pragma unroll
            for (int m = 0; m < 4; ++m) {
                const int row = row0 + ai * 128 + m * 16;
#pragma unroll
                for (int bj = 0; bj < 2; ++bj) {
                    bf16_t* dst = strip ? US + us_off(row, col0 + bj * 128) : U + (size_t)row * NIN_ + col0 + bj * 128;
                    float o[8];
#pragma unroll
                    for (int e = 0; e < 8; ++e) {
                        const float v = (e < 4) ? acc[ai][bj][m][0][e & 3] : acc[ai][bj][m][1][e & 3];
                        const float lbv = (e < 4) ? l0[bj][e & 3] : l1[bj][e & 3];
                        float r;
                        if (MODE == 0) r = v * scale;
                        else if (MODE == 1) r = v * fsigmoid(v) * scale;
                        else if (MODE == 2) r = fsigmoid(v);
                        else r = __logf(lbv + (1.0f - lbv) * fsigmoid(v));
                        o[e] = r;
                    }
                    u32x4 pk = {pk2(o[0], o[1]), pk2(o[2], o[3]), pk2(o[4], o[5]), pk2(o[6], o[7])};
                    st_nt((u32x4*)dst, pk);
                }
            }
    }
    DI void operator()(const f32x4 (&acc)[2][2][4][2], const pg8::Unit& u, int wr, int wc, int fr, int fq) const {
        const int pn = u.pn;
        if (pn < 4) run<1>(acc, u, wr, wc, fr, fq, 0.08838834764831845f);
        else if (pn < 8) run<3>(acc, u, wr, wc, fr, fq, 1.f);
        else if (pn < 12) run<0>(acc, u, wr, wc, fr, fq, 1.f);
        else if (pn < 16) run<1>(acc, u, wr, wc, fr, fq, 1.f);
        else if (pn < 20) run<0>(acc, u, wr, wc, fr, fq, 0.125f);
        else if (pn < 22) run<0>(acc, u, wr, wc, fr, fq, 1.f);
        else if (pn < 26) run<1>(acc, u, wr, wc, fr, fq, 1.f);
        else if (pn < 42) {
            const bool isH = pn < 34;
            bf16_t* dstb = (isH ? U : U + (size_t)M_ * 1024) + (size_t)((pn - (isH ? 26 : 34)) * 128 + wc * 32 + 8 * fq);
            const int row0 = u.pm * 256 + wr * 64 + fr;
#pragma unroll
            for (int ai = 0; ai < 2; ++ai)
#pragma unroll
                for (int m = 0; m < 4; ++m) {
                    float o[8];
#pragma unroll
                    for (int e = 0; e < 8; ++e) {
                        const float a = (e < 4) ? acc[ai][0][m][0][e & 3] : acc[ai][0][m][1][e & 3], bq = (e < 4) ? acc[ai][1][m][0][e & 3] : acc[ai][1][m][1][e & 3];
                        o[e] = isH ? a * bq : a * (bq * fsigmoid(bq));
                    }
                    u32x4 pk = {pk2(o[0], o[1]), pk2(o[2], o[3]), pk2(o[4], o[5]), pk2(o[6], o[7])};
                    st_nt((u32x4*)(dstb + (size_t)(row0 + ai * 128 + m * 16) * 1024), pk);
                }
        }
        else {
            unsigned char* tp = (unsigned char*)GT + (size_t)((((pn - 42) >> 3) * 64 + u.pm) * 8 + ((pn - 42) & 7)) * 65536 + (size_t)(((wr * 4 + wc) * 64 + fq * 16 + fr) * 8);
#pragma unroll
            for (int ai = 0; ai < 2; ++ai)
#pragma unroll
                for (int m = 0; m < 4; ++m)
#pragma unroll
                    for (int bj = 0; bj < 2; ++bj) {
                        const f32x4 v0 = acc[ai][bj][m][0], v1 = acc[ai][bj][m][1];
                        unsigned q[8];
#pragma unroll
                        for (int e = 0; e < 4; ++e) { q[e] = (unsigned)(fsigmoid(v0[e]) * 255.0f + 0.5f); q[4 + e] = (unsigned)(fsigmoid(v1[e]) * 255.0f + 0.5f); }
                        u32x2 pk = {q[0] | (q[1] << 8) | (q[2] << 16) | (q[3] << 24), q[4] | (q[5] << 8) | (q[6] << 16) | (q[7] << 24)};
                        st_nt((u32x2*)(tp + ((ai * 4 + m) * 2 + bj) * 4096), pk);
                    }
        }
    }
};
struct EpiMerge {
    static constexpr bool PERM = true, AFTER_DRAIN = false;
    const unsigned char* GTb; bf16_t* MP; bf16_t* Mg; int br;
    DI void operator()(const f32x4 (&acc)[2][2][4][2], const pg8::Unit& u, int wr, int wc, int fr, int fq) const {
        const int row0 = u.pm * 256 + wr * 64 + fr, col0 = u.pn * 256 + wc * 32 + 8 * fq;
        const size_t toff = (size_t)(u.pm * 8 + u.pn) * 65536 + (size_t)(((wr * 4 + wc) * 64 + fq * 16 + fr) * 8);
        const unsigned char* gp = GTb + toff; bf16_t* pp = MP + toff;
        u32x2 gv[16];
#pragma unroll
        for (int r = 0; r < 16; ++r) gv[r] = ld_nt((const u32x2*)(gp + r * 4096));
#pragma unroll
        for (int r0 = 0; r0 < 16; r0 += 8) {
            u32x4 pv[8];
#pragma unroll
            for (int rr = 0; rr < 8; ++rr) { pv[rr] = (u32x4){0u, 0u, 0u, 0u}; if (br != 0) pv[rr] = ld_nt((const u32x4*)(pp + (r0 + rr) * 4096)); }
#pragma unroll
            for (int rr = 0; rr < 8; ++rr) {
                const int r = r0 + rr, ai = r >> 3, m = (r >> 1) & 3, bj = r & 1;
                float g[8], p[8], o[8];
#pragma unroll
                for (int e = 0; e < 8; ++e) g[e] = (float)((gv[r][e >> 2] >> (8 * (e & 3))) & 0xffu) * (1.0f / 255.0f);
                unpack8(pv[rr], p);
#pragma unroll
                for (int e = 0; e < 8; ++e) { const float a = (e < 4) ? acc[ai][bj][m][0][e & 3] : acc[ai][bj][m][1][e & 3]; o[e] = p[e] + g[e] * a; }
                u32x4 pk = {pk2(o[0], o[1]), pk2(o[2], o[3]), pk2(o[4], o[5]), pk2(o[6], o[7])};
                if (br != 2) st_nt((u32x4*)(pp + r * 4096), pk);
                else *(u32x4*)(Mg + (size_t)(row0 + ai * 128 + m * 16) * D_ + col0 + bj * 128) = pk;
            }
        }
    }
};
struct EpiOut {
    static constexpr bool PERM = true, AFTER_DRAIN = false;
    bf16_t* Y;
    DI void operator()(const f32x4 (&acc)[2][2][4][2], const pg8::Unit& u, int wr, int wc, int fr, int fq) const {
        const int row0 = u.pm * 256 + wr * 64 + fr, col0 = u.pn * 256 + wc * 32 + 8 * fq;
#pragma unroll
        for (int ai = 0; ai < 2; ++ai)
#pragma unroll
            for (int m = 0; m < 4; ++m) {
                bf16_t* rowp = Y + (size_t)(row0 + ai * 128 + m * 16) * D_ + col0;
#pragma unroll
                for (int bj = 0; bj < 2; ++bj) {
                    const f32x4 v0 = acc[ai][bj][m][0], v1 = acc[ai][bj][m][1];
                    u32x4 pk = {pk2(v0[0], v0[1]), pk2(v0[2], v0[3]), pk2(v1[0], v1[1]), pk2(v1[2], v1[3])};
                    st_nt((u32x4*)(rowp + bj * 128), pk);
                }
            }
    }
};

DI int win_block_perm(int b) { if (b < 52 || b >= 84) return b; const int s4 = (b - 52) >> 3, t = (b - 52) & 7; return s4 == 1 ? 52 + 2 * t : (s4 == 2 ? 53 + 2 * t : (s4 == 0 ? 68 + 2 * t : 69 + 2 * t)); }
template <bool PERMW = false> DI void transpose_convert(LAS unsigned char* lds, const float* W, bf16_t* Wt, int K, int N, int wg, int nwg, int t_lo = 0, int t_hi = 1 << 30) {
    LAS float* T = (LAS float*)lds;
    const int tid = otid(), tn = N / 128, nt = (tn * (K / 64)) < t_hi ? (tn * (K / 64)) : t_hi;
    f32x4 nv[4];
#define TC_LOAD(t_) do { const int _k0 = ((t_) / tn) * 64, _n0 = ((t_) % tn) * 128; \
        _Pragma("unroll") for (int e = 0; e < 4; ++e) { const int idx = tid + 512 * e, kk = idx >> 5, n4 = (idx & 31) * 4; nv[e] = *(const f32x4*)(W + (size_t)(_k0 + kk) * N + _n0 + n4); } } while (0)
    if (t_lo + wg < nt) TC_LOAD(t_lo + wg);
    for (int t = t_lo + wg; t < nt; t += nwg) {
        const int k0 = (t / tn) * 64, n0 = (t % tn) * 128;
#pragma unroll
        for (int e = 0; e < 4; ++e) {
            const int idx = tid + 512 * e, kk = idx >> 5, n4 = (idx & 31) * 4;
            T[kk * 129 + n4 + 0] = nv[e][0]; T[kk * 129 + n4 + 1] = nv[e][1]; T[kk * 129 + n4 + 2] = nv[e][2]; T[kk * 129 + n4 + 3] = nv[e][3];
        }
        __syncthreads();
        if (t + nwg < nt) TC_LOAD(t + nwg);
#pragma unroll
        for (int e = 0; e < 2; ++e) {
            const int idx = tid + 512 * e, n = idx >> 3, kg = idx & 7;
            float o[8];
#pragma unroll
            for (int j = 0; j < 8; ++j) o[j] = T[(kg * 8 + j) * 129 + n];
            u32x4 pk = {pk2(o[0], o[1]), pk2(o[2], o[3]), pk2(o[4], o[5]), pk2(o[6], o[7])};
            const int nd = PERMW ? win_block_perm(n0 >> 7) * 128 + n : n0 + n;
            *(u32x4*)(Wt + (size_t)nd * K + k0 + kg * 8) = pk;
        }
        __syncthreads();
    }
#undef TC_LOAD
}
constexpr int CVT_SPLIT = 2688;
DI void convert_layer_weights(LAS unsigned char* lds, const Params& p, unsigned char* ws, int l, int wg, int nwg, int part) {
    if (part != 2) transpose_convert<true>(lds, p.w_in + (size_t)l * D_ * NIN_, (bf16_t*)(ws + WS_WIN) + (size_t)l * NIN_ * D_, D_, NIN_, wg, nwg, 0, part == 0 ? (1 << 30) : CVT_SPLIT);
    if (part == 1) return;
    if (part == 2) transpose_convert<true>(lds, p.w_in + (size_t)l * D_ * NIN_, (bf16_t*)(ws + WS_WIN) + (size_t)l * NIN_ * D_, D_, NIN_, wg, nwg, CVT_SPLIT);
    transpose_convert(lds, p.w_pa + (size_t)l * 1024 * D_, (bf16_t*)(ws + WS_WPA) + (size_t)l * D_ * 1024, 1024, D_, wg, nwg);
    transpose_convert(lds, p.w_pb + (size_t)l * 1024 * D_, (bf16_t*)(ws + WS_WPB) + (size_t)l * D_ * 1024, 1024, D_, wg, nwg);
    transpose_convert(lds, p.w_pc + (size_t)l * 1024 * D_, (bf16_t*)(ws + WS_WPC) + (size_t)l * D_ * 1024, 1024, D_, wg, nwg);
    transpose_convert(lds, p.w_out + (size_t)l * D_ * D_, (bf16_t*)(ws + WS_WOUT) + (size_t)l * D_ * D_, D_, D_, wg, nwg);
}

DI float wave_sum(float v) {
#pragma unroll
    for (int o = 32; o >= 1; o >>= 1) v += __shfl_xor(v, o);
    return v;
}

template <bool FIRST, bool LAST> DI void ln_phase(const float* Xin, const bf16_t* Y, float* out, bf16_t* XB, unsigned char* XL, const float* g, const float* b, int wg, int nwg) {
    const int tid = otid(), lane = tid & 63, wave = tid >> 6;
    f32x4 nx[8]; u32x2 ny[8], nh[8]; unsigned nl[8];
#define LN_LOAD(row_) do { const size_t _ro = (size_t)(row_) * D_; _Pragma("unroll") for (int e = 0; e < 8; ++e) { const int c = e * 256 + lane * 4; ny[e] = ld_nt((const u32x2*)(Y + _ro + c)); \
        if (FIRST) nx[e] = *(const f32x4*)(Xin + _ro + c); else { nh[e] = ld_nt((const u32x2*)(XB + _ro + c)); nl[e] = *(const unsigned*)(XL + _ro + c); } } } while (0)
    f32x4 gg8[8], bb8[8];
#pragma unroll
    for (int e = 0; e < 8; ++e) { gg8[e] = *(const f32x4*)(g + e * 256 + lane * 4); bb8[e] = *(const f32x4*)(b + e * 256 + lane * 4); }
    int row = wg * 8 + wave;
    if (row < M_) LN_LOAD(row);
    for (; row < M_; row += nwg * 8) {
        const size_t ro = (size_t)row * D_;
        f32x4 v[8];
        float s = 0.f;
#pragma unroll
        for (int e = 0; e < 8; ++e) {
            if (FIRST) v[e] = nx[e];
            else {
                const int w = (int)nl[e];
                v[e] = (f32x4){bf_lo(nh[e][0]) + (float)((w << 24) >> 24) * (1.0f / 8192.0f), bf_hi(nh[e][0]) + (float)((w << 16) >> 24) * (1.0f / 8192.0f),
                               bf_lo(nh[e][1]) + (float)((w << 8) >> 24) * (1.0f / 8192.0f), bf_hi(nh[e][1]) + (float)(w >> 24) * (1.0f / 8192.0f)};
            }
            const f32x4 yy = {bf_lo(ny[e][0]), bf_hi(ny[e][0]), bf_lo(ny[e][1]), bf_hi(ny[e][1])};
            v[e] = v[e] * ALPHA_ + yy;
            s += (v[e][0] + v[e][1]) + (v[e][2] + v[e][3]);
        }
        if (row + nwg * 8 < M_) LN_LOAD(row + nwg * 8);
        const float mu = wave_sum(s) * (1.0f / 2048.0f);
        float ss = 0.f;
#pragma unroll
        for (int e = 0; e < 8; ++e) { v[e] = v[e] - mu; ss += (v[e][0] * v[e][0] + v[e][1] * v[e][1]) + (v[e][2] * v[e][2] + v[e][3] * v[e][3]); }
        const float rstd = rsqrtf(wave_sum(ss) * (1.0f / 2048.0f) + 1e-5f);
#pragma unroll
        for (int e = 0; e < 8; ++e) {
            const int c = e * 256 + lane * 4;
            const f32x4 y = v[e] * rstd * gg8[e] + bb8[e];
            if (LAST) *(f32x4*)(out + ro + c) = y;
            else {
                const u32x2 hi = {pk2(y[0], y[1]), pk2(y[2], y[3])};
                const float d0 = fminf(fmaxf(rintf((y[0] - bf_lo(hi[0])) * 8192.0f), -127.f), 127.f), d1 = fminf(fmaxf(rintf((y[1] - bf_hi(hi[0])) * 8192.0f), -127.f), 127.f);
                const float d2 = fminf(fmaxf(rintf((y[2] - bf_lo(hi[1])) * 8192.0f), -127.f), 127.f), d3 = fminf(fmaxf(rintf((y[3] - bf_hi(hi[1])) * 8192.0f), -127.f), 127.f);
                const unsigned lo = ((unsigned)(int)d0 & 0xffu) | (((unsigned)(int)d1 & 0xffu) << 8) | (((unsigned)(int)d2 & 0xffu) << 16) | ((unsigned)(int)d3 << 24);
                *(u32x2*)(XB + ro + c) = hi; *(unsigned*)(XL + ro + c) = lo;
            }
        }
    }
#undef LN_LOAD
}

DI void conv_phase(const bf16_t* HB, const bf16_t* PB, bf16_t* GC, const float* cw, int wg, int nwg) {
    for (int task = wg * 512 + otid(); task < 131072; task += nwg * 512) {
        const int ch0 = (task & 127) * 8, tok0 = (task >> 7) * 16;
        float w0[8], w1[8], w2[8], h1[8], h2[8];
#pragma unroll
        for (int e = 0; e < 8; ++e) { w0[e] = cw[ch0 + e]; w1[e] = cw[1024 + ch0 + e]; w2[e] = cw[2048 + ch0 + e]; h1[e] = 0.f; h2[e] = 0.f; }
        if ((tok0 & (SEQ_ - 1)) != 0) { unpack8(*(const u32x4*)(HB + (size_t)(tok0 - 1) * 1024 + ch0), h1); unpack8(*(const u32x4*)(HB + (size_t)(tok0 - 2) * 1024 + ch0), h2); }
        u32x4 nh, np;
        nh = *(const u32x4*)(HB + (size_t)tok0 * 1024 + ch0); np = *(const u32x4*)(PB + (size_t)tok0 * 1024 + ch0);
#pragma unroll 2
        for (int i = 0; i < 16; ++i) {
            float h0[8], pb[8], o[8];
            unpack8(nh, h0); unpack8(np, pb);
            if (i < 15) { nh = *(const u32x4*)(HB + (size_t)(tok0 + i + 1) * 1024 + ch0); np = *(const u32x4*)(PB + (size_t)(tok0 + i + 1) * 1024 + ch0); }
#pragma unroll
            for (int e = 0; e < 8; ++e) {
                o[e] = pb[e] * (w0[e] * h2[e] + w1[e] * h1[e] + w2[e] * h0[e]);
                h2[e] = h1[e]; h1[e] = h0[e];
            }
            u32x4 pk = {pk2(o[0], o[1]), pk2(o[2], o[3]), pk2(o[4], o[5]), pk2(o[6], o[7])};
            *(u32x4*)(GC + (size_t)(tok0 + i) * 1024 + ch0) = pk;
        }
    }
}

constexpr int HL_G = 0, HL_B = 32768, HL_TOT = 65536, HL_RED = 67584;
constexpr int H1_VT = 68096, H1_KET = H1_VT + 128 * 72 * 2;
constexpr int H3_QE = 68096, H3_QM = H3_QE + 64 * 136 * 2, H3_KM = H3_QM + 64 * 136 * 2, H3_VT = H3_KM + 64 * 136 * 2;
static_assert(H3_VT + 128 * 72 * 2 <= LDS_BYTES, "LDS");

struct HStage { u32x4 g[2], v[2], q[2]; };
template <bool WITH_Q> DI void hgrn_load(HStage& st, const bf16_t* U, int it, int tid) {
    const int c = it & 127, bh = it >> 7, b = bh >> 3, h = bh & 7, row0 = b * SEQ_ + c * 64;
#pragma unroll
    for (int e = 0; e < 2; ++e) {
        const int id = tid + 512 * e, t = id >> 4, c8 = (id & 15) * 8;
        const bf16_t* up = U + us_off(row0 + t, h * 128 + c8);
        st.g[e] = *(const u32x4*)(up + (size_t)(UC_AF >> 5) * M_ * 32); st.v[e] = *(const u32x4*)(up + (size_t)(UC_AI >> 5) * M_ * 32);
        if (WITH_Q) st.q[e] = *(const u32x4*)(up + (size_t)(UC_AQ >> 5) * M_ * 32);
    }
}
template <bool WITH_Q> DI void hgrn_commit(const HStage& st, LAS unsigned char* lds, int vt_off, int q_off, int tid) {
    LAS float* gL = (LAS float*)(lds + HL_G); LAS float* bL = (LAS float*)(lds + HL_B); LAS float* tot = (LAS float*)(lds + HL_TOT);
    LAS bf16_t* vT = (LAS bf16_t*)(lds + vt_off);
#pragma unroll
    for (int e = 0; e < 2; ++e) {
        const int id = tid + 512 * e, t = id >> 4, c8 = (id & 15) * 8;
        float gf[8]; unpack8(st.g[e], gf);
        *(LAS f32x4*)(gL + t * 128 + c8) = (f32x4){gf[0], gf[1], gf[2], gf[3]};
        *(LAS f32x4*)(gL + t * 128 + c8 + 4) = (f32x4){gf[4], gf[5], gf[6], gf[7]};
        const u32x4 vv = st.v[e];
#pragma unroll
        for (int j = 0; j < 4; ++j) { const int ts = t ^ ((id & 7) * 8); vT[(c8 + 2 * j) * 72 + ts] = (bf16_t)(vv[j] & 0xffffu); vT[(c8 + 2 * j + 1) * 72 + ts] = (bf16_t)(vv[j] >> 16); }
        if (WITH_Q) *(LAS u32x4*)((LAS bf16_t*)(lds + q_off) + t * 136 + c8) = st.q[e];
    }
    __syncthreads();
    {
        const int k = tid & 127, part = tid >> 7;
        float run = 0.f;
#pragma unroll
        for (int i = 0; i < 16; ++i) { const int t = part * 16 + i; run += gL[t * 128 + k]; bL[t * 128 + k] = run; }
        tot[part * 128 + k] = run;
    }
    __syncthreads();
}

DI void hgrn_local_phase(LAS unsigned char* lds, const bf16_t* U, bf16_t* DS, float* DEC, int wg, int nwg) {
    LAS float* gL = (LAS float*)(lds + HL_G); LAS float* bL = (LAS float*)(lds + HL_B); LAS float* tot = (LAS float*)(lds + HL_TOT);
    LAS bf16_t* vT = (LAS bf16_t*)(lds + H1_VT); LAS bf16_t* keT = (LAS bf16_t*)(lds + H1_KET);
    const int tid = otid(), lane = tid & 63, w = tid >> 6, fr = lane & 15, fq = lane >> 4;
    HStage st;
    if (wg < 2048) hgrn_load<false>(st, U, wg, tid);
    for (int it = wg; it < 2048; it += nwg) {
        hgrn_commit<false>(st, lds, H1_VT, 0, tid);
        if (it + nwg < 2048) hgrn_load<false>(st, U, it + nwg, tid);
        {
            const int k = tid & 127, sg = tid >> 7;
            const float t0 = tot[k], t1 = tot[128 + k], t2 = tot[256 + k], t3 = tot[384 + k];
            const float bend = (t0 + t1) + (t2 + t3);
            const float pre = sg == 0 ? 0.f : (sg == 1 ? t0 : (sg == 2 ? t0 + t1 : t0 + t1 + t2));
            unsigned pk[8];
#pragma unroll
            for (int i = 0; i < 16; i += 2) {
                const int s = sg * 16 + i;
                const float ke0 = (1.0f - __expf(gL[s * 128 + k])) * __expf(bend - (bL[s * 128 + k] + pre));
                const float ke1 = (1.0f - __expf(gL[(s + 1) * 128 + k])) * __expf(bend - (bL[(s + 1) * 128 + k] + pre));
                pk[i >> 1] = pk2(ke0, ke1);
            }
            *(LAS u32x4*)(keT + k * 72 + sg * 16) = (u32x4){pk[0], pk[1], pk[2], pk[3]};
            *(LAS u32x4*)(keT + k * 72 + sg * 16 + 8) = (u32x4){pk[4], pk[5], pk[6], pk[7]};
            if (sg == 0) DEC[(size_t)it * 128 + k] = __expf(bend);
        }
        __syncthreads();
        {
            bf16x8 a[2];
#pragma unroll
            for (int ks = 0; ks < 2; ++ks) a[ks] = *(const LAS bf16x8*)(keT + (16 * w + fr) * 72 + ks * 32 + 8 * fq);
#pragma unroll
            for (int vt = 0; vt < 8; ++vt) {
                f32x4 acc = {0.f, 0.f, 0.f, 0.f};
#pragma unroll
                for (int ks = 0; ks < 2; ++ks) { const bf16x8 bb = *(const LAS bf16x8*)(vT + (16 * vt + fr) * 72 + ((ks * 32 + 8 * fq) ^ (((2 * vt + (fr >> 3)) & 7) * 8))); acc = mfma16(a[ks], bb, acc); }
                u32x2 pkd = {pk2(acc[0], acc[1]), pk2(acc[2], acc[3])};
                *(u32x2*)(DS + (size_t)it * 16384 + (16 * vt + fr) * 128 + 16 * w + 4 * fq) = pkd;
            }
        }
        __syncthreads();
    }
}

DI void hgrn_scan_phase(LAS unsigned char* lds, const bf16_t* DS, const float* DEC, bf16_t* SIN, int wg, int nwg) {
    LAS float* dL = (LAS float*)lds;
    const int tid = otid();
    for (int slice = wg; slice < 256; slice += nwg) {
        const int gt = slice * 512 + tid, bh = gt >> 13, rem = gt & 8191, v = rem >> 6, k2 = (rem & 63) * 2;
        const size_t base = (size_t)bh * 128;
        f32x4 dv[8];
#pragma unroll
        for (int e = 0; e < 8; ++e) dv[e] = *(const f32x4*)(DEC + base * 128 + (size_t)(tid + 512 * e) * 4);
        __builtin_amdgcn_sched_barrier(0);
#pragma unroll
        for (int e = 0; e < 8; ++e) *(LAS f32x4*)(dL + (tid + 512 * e) * 4) = dv[e];
        __syncthreads();
        const bf16_t* dsp = DS + base * 16384 + v * 128 + k2; bf16_t* sp = SIN + base * 16384 + v * 128 + k2;
        f32x2 st = {0.f, 0.f};
        unsigned bA[16], bB[16];
#define SC_LOAD(buf, c0) do { _Pragma("unroll") for (int j = 0; j < 16; ++j) buf[j] = *(const unsigned*)(dsp + (size_t)((c0) + j) * 16384); } while (0)
#define SC_STEP(buf, c0) do { _Pragma("unroll") for (int j = 0; j < 16; ++j) { const f32x2 d2 = *(const LAS f32x2*)(dL + ((c0) + j) * 128 + k2); \
            *(unsigned*)(sp + (size_t)((c0) + j) * 16384) = pk2(st[0], st[1]); const f32x2 dl = {bf_lo(buf[j]), bf_hi(buf[j])}; st = d2 * st + dl; } } while (0)
        SC_LOAD(bA, 0);
#pragma unroll 1
        for (int c0 = 0; c0 < 128; c0 += 32) {
            SC_LOAD(bB, c0 + 16);
            SC_STEP(bA, c0);
            if (c0 + 32 < 128) SC_LOAD(bA, c0 + 32);
            SC_STEP(bB, c0 + 16);
        }
#undef SC_LOAD
#undef SC_STEP
        __syncthreads();
    }
}

DI void hgrn_out_phase(LAS unsigned char* lds, const bf16_t* U, const bf16_t* SIN, bf16_t* GA, const float* ng, int wg, int nwg) {
    LAS float* gL = (LAS float*)(lds + HL_G); LAS float* bL = (LAS float*)(lds + HL_B); LAS float* tot = (LAS float*)(lds + HL_TOT); LAS float* red = (LAS float*)(lds + HL_RED);
    LAS bf16_t* qeL = (LAS bf16_t*)(lds + H3_QE); LAS bf16_t* qmL = (LAS bf16_t*)(lds + H3_QM); LAS bf16_t* kmL = (LAS bf16_t*)(lds + H3_KM); LAS bf16_t* vT = (LAS bf16_t*)(lds + H3_VT);
    const int tid = otid(), lane = tid & 63, w = tid >> 6, fr = lane & 15, fq = lane >> 4;
    const int tt = w & 3, vh = w >> 2;
    HStage st;
    bf16x8 sA[4][4]; u32x2 gatev[4];
#define H3_LOAD_SA(item) do { const int _c = (item) & 127, _bh = (item) >> 7, _row0 = (_bh >> 3) * SEQ_ + _c * 64, _h = _bh & 7; \
        _Pragma("unroll") for (int vi = 0; vi < 4; ++vi) { const int v = 16 * (vh * 4 + vi) + fr; \
            _Pragma("unroll") for (int ks = 0; ks < 4; ++ks) sA[vi][ks] = *(const bf16x8*)(SIN + (size_t)(item) * 16384 + v * 128 + ks * 32 + 8 * fq); \
            gatev[vi] = *(const u32x2*)(U + us_off(_row0 + 16 * tt + fr, UC_AG + _h * 128 + 16 * (vh * 4 + vi) + 4 * fq)); } } while (0)
    if (wg < 2048) hgrn_load<true>(st, U, wg, tid);
    for (int it = wg; it < 2048; it += nwg) {
        const int c = it & 127, bh = it >> 7, b = bh >> 3, h = bh & 7, row0 = b * SEQ_ + c * 64;
        H3_LOAD_SA(it);
        hgrn_commit<true>(st, lds, H3_VT, H3_QE, tid);
        if (it + nwg < 2048) hgrn_load<true>(st, U, it + nwg, tid);
        {
            const int k = tid & 127, tg = tid >> 7;
            const float t0 = tot[k], t1 = tot[128 + k], t2 = tot[256 + k];
            const float pre = tg == 0 ? 0.f : (tg == 1 ? t0 : (tg == 2 ? t0 + t1 : t0 + t1 + t2));
            const float r = t0 + bL[31 * 128 + k];
#pragma unroll 4
            for (int i = 0; i < 16; ++i) {
                const int t = tg * 16 + i;
                const float bt = bL[t * 128 + k] + pre, gt = gL[t * 128 + k];
                const float qf = bf1(qeL[t * 136 + k]);
                qeL[t * 136 + k] = f2bf(qf * __expf(bt));
                qmL[t * 136 + k] = f2bf(qf * __expf(bt - r));
                kmL[t * 136 + k] = f2bf((1.0f - __expf(gt)) * __expf(r - bt));
            }
        }
        __syncthreads();
        f32x4 acc[4];
#pragma unroll
        for (int vi = 0; vi < 4; ++vi) acc[vi] = (f32x4){0.f, 0.f, 0.f, 0.f};
        {
            bf16x8 qmf[4];
#pragma unroll
            for (int ks = 0; ks < 4; ++ks) qmf[ks] = *(const LAS bf16x8*)(qmL + (16 * tt + fr) * 136 + ks * 32 + 8 * fq);
            f32x4 sc[4];
#pragma unroll
            for (int st = 0; st < 4; ++st) {
                sc[st] = (f32x4){0.f, 0.f, 0.f, 0.f};
                if (st <= tt) {
#pragma unroll
                    for (int ks = 0; ks < 4; ++ks) { const bf16x8 a = *(const LAS bf16x8*)(kmL + (16 * st + fr) * 136 + ks * 32 + 8 * fq); sc[st] = mfma16(a, qmf[ks], sc[st]); }
                    if (st == tt) {
#pragma unroll
                        for (int j = 0; j < 4; ++j) sc[st][j] = (4 * fq + j <= fr) ? sc[st][j] : 0.f;
                    }
                }
            }
#pragma unroll
            for (int p = 0; p < 2; ++p) {
                if (2 * p <= tt) {
                    const u32x4 pku = {pk2(sc[2 * p][0], sc[2 * p][1]), pk2(sc[2 * p][2], sc[2 * p][3]), pk2(sc[2 * p + 1][0], sc[2 * p + 1][1]), pk2(sc[2 * p + 1][2], sc[2 * p + 1][3])};
                    const bf16x8 P = __builtin_bit_cast(bf16x8, pku);
#pragma unroll
                    for (int vi = 0; vi < 4; ++vi) {
                        const int v = 16 * (vh * 4 + vi) + fr;
                        const int swr = ((2 * (vh * 4 + vi) + (fr >> 3)) & 7) * 8;
                        const u32x2 lo = *(const LAS u32x2*)(vT + v * 72 + ((32 * p + 4 * fq) ^ swr)), hi = *(const LAS u32x2*)(vT + v * 72 + ((32 * p + 16 + 4 * fq) ^ swr));
                        const u32x4 au = {lo[0], lo[1], hi[0], hi[1]};
                        acc[vi] = mfma16(__builtin_bit_cast(bf16x8, au), P, acc[vi]);
                    }
                }
            }
#pragma unroll
            for (int ks = 0; ks < 4; ++ks) {
                const bf16x8 bq = *(const LAS bf16x8*)(qeL + (16 * tt + fr) * 136 + ks * 32 + 8 * fq);
#pragma unroll
                for (int vi = 0; vi < 4; ++vi) {
                    acc[vi] = mfma16(sA[vi][ks], bq, acc[vi]);
                }
            }
        }
        float ss = 0.f;
#pragma unroll
        for (int vi = 0; vi < 4; ++vi) ss += (acc[vi][0] * acc[vi][0] + acc[vi][1] * acc[vi][1]) + (acc[vi][2] * acc[vi][2] + acc[vi][3] * acc[vi][3]);
        ss += __shfl_xor(ss, 16); ss += __shfl_xor(ss, 32);
        if (fq == 0) red[vh * 64 + 16 * tt + fr] = ss;
        __syncthreads();
        {
            const float tot2 = red[16 * tt + fr] + red[64 + 16 * tt + fr];
            const float rinv = rsqrtf(tot2 * (1.0f / 128.0f) + 1e-6f);
            const size_t trow = (size_t)(row0 + 16 * tt + fr);
            f32x4 g4v[4];
#pragma unroll
            for (int vi = 0; vi < 4; ++vi) g4v[vi] = *(const f32x4*)(ng + h * 128 + 16 * (vh * 4 + vi) + 4 * fq);
#pragma unroll
            for (int vi = 0; vi < 4; ++vi) {
                const int vb = h * 128 + 16 * (vh * 4 + vi) + 4 * fq;
                const f32x4 g4 = g4v[vi];
                const u32x2 gate = gatev[vi];
                const float o0 = acc[vi][0] * rinv * g4[0] * bf_lo(gate[0]), o1 = acc[vi][1] * rinv * g4[1] * bf_hi(gate[0]);
                const float o2 = acc[vi][2] * rinv * g4[2] * bf_lo(gate[1]), o3 = acc[vi][3] * rinv * g4[3] * bf_hi(gate[1]);
                u32x2 pk = {pk2(o0, o1), pk2(o2, o3)};
                *(u32x2*)(GA + trow * 1024 + vb) = pk;
            }
        }
        __syncthreads();
    }
#undef H3_LOAD_SA
}

constexpr int AT_K = 0, AT_VT = 256 * 72 * 2, AT_BIAS = AT_VT + 256 * 72 * 2;
DI void attn_phase(LAS unsigned char* lds, const bf16_t* U, bf16_t* GB, const float* BIAS, const float* sinks, int wg, int nwg) {
    LAS bf16_t* Kl = (LAS bf16_t*)(lds + AT_K); LAS bf16_t* Vt = (LAS bf16_t*)(lds + AT_VT); LAS float* biasL = (LAS float*)(lds + AT_BIAS);
    const int tid = otid(), lane = tid & 63, w = tid >> 6, fr = lane & 15, fq = lane >> 4;
    u32x4 pkv[4], pvv[4];
#define AT_LOAD_KV(item) do { const int _kvh = (item) & 3, _blk = ((item) >> 2) & 63, _b = (item) >> 8, _rc0 = _b * SEQ_ + _blk * 128, _rp0 = _blk > 0 ? _rc0 - 128 : _rc0; \
        _Pragma("unroll") for (int e = 0; e < 4; ++e) { const int id = tid + 512 * e, j = id >> 3, c8 = (id & 7) * 8; const int row = j < 128 ? _rp0 + j : _rc0 + j - 128; \
            pkv[e] = *(const u32x4*)(U + us_off(row, UC_BK + _kvh * 64 + c8)); pvv[e] = *(const u32x4*)(U + us_off(row, UC_BV + _kvh * 64 + c8)); } } while (0)
    if (wg < 512) AT_LOAD_KV(wg);
    for (int it = wg; it < 512; it += nwg) {
        const int kvh = it & 3, blk = (it >> 2) & 63, b = it >> 8;
        const int rc0 = b * SEQ_ + blk * 128;
        bf16x8 qn[2]; u32x2 gn[4];
#define AT_LOAD_Q(unit_) do { const int _g = (unit_) >> 3, _mt = (unit_) & 7, _hq = kvh * 4 + _g; const int _qrow = rc0 + 16 * _mt + fr; \
        _Pragma("unroll") for (int ks = 0; ks < 2; ++ks) qn[ks] = *(const bf16x8*)(U + us_off(_qrow, UC_BQ + _hq * 64 + ks * 32 + 8 * fq)); \
        _Pragma("unroll") for (int dt = 0; dt < 4; ++dt) gn[dt] = *(const u32x2*)(U + us_off(_qrow, UC_BG + _hq * 64 + 16 * dt + 4 * fq)); } while (0)
        const float sk0 = sinks[kvh * 4 + 0], sk1 = sinks[kvh * 4 + 1], sk2 = sinks[kvh * 4 + 2], sk3 = sinks[kvh * 4 + 3];
        AT_LOAD_Q(w * 4);
#pragma unroll
        for (int e = 0; e < 4; ++e) {
            const int id = tid + 512 * e, j = id >> 3, c8 = (id & 7) * 8;
            *(LAS u32x4*)(Kl + j * 72 + c8) = pkv[e];
            *(LAS u32x4*)(Vt + j * 72 + c8) = pvv[e];
        }
        biasL[tid] = BIAS[(kvh * 4 + (tid >> 7)) * 128 + (tid & 127)];
        __syncthreads();
        if (it + nwg < 512) AT_LOAD_KV(it + nwg);
#pragma unroll 1
        for (int e = 0; e < 4; ++e) {
            const int unit = w * 4 + e, g = unit >> 3, mt = unit & 7, hq = kvh * 4 + g;
            const size_t qrow = (size_t)(rc0 + 16 * mt + fr);
            bf16x8 qf[2]; u32x2 gcur[4];
#pragma unroll
            for (int ks = 0; ks < 2; ++ks) qf[ks] = qn[ks];
#pragma unroll
            for (int dt = 0; dt < 4; ++dt) gcur[dt] = gn[dt];
            if (e < 3) AT_LOAD_Q(unit + 1);
            f32x4 sc[9];
#pragma unroll
            for (int n = 0; n < 9; ++n) {
                sc[n] = (f32x4){0.f, 0.f, 0.f, 0.f};
#pragma unroll
                for (int ks = 0; ks < 2; ++ks) { const bf16x8 a = *(const LAS bf16x8*)(Kl + (16 * (mt + n) + fr) * 72 + ks * 32 + 8 * fq); sc[n] = mfma16(a, qf[ks], sc[n]); }
            }
            float mx = -INFINITY;
#pragma unroll
            for (int n = 0; n < 9; ++n)
#pragma unroll
                for (int j = 0; j < 4; ++j) {
                    const int rel = 128 + fr - 16 * n - 4 * fq - j, jidx = 16 * (mt + n) + 4 * fq + j;
                    const bool valid = (rel >= 0) && (rel <= 127) && (blk > 0 || jidx >= 128);
                    const int relc = rel < 0 ? 0 : (rel > 127 ? 127 : rel);
                    const float s = valid ? sc[n][j] + biasL[g * 128 + relc] : -INFINITY;
                    sc[n][j] = s; mx = fmaxf(mx, s);
                }
            mx = fmaxf(mx, __shfl_xor(mx, 16)); mx = fmaxf(mx, __shfl_xor(mx, 32));
            const float sink = g == 0 ? sk0 : (g == 1 ? sk1 : (g == 2 ? sk2 : sk3));
            const float mm = fmaxf(mx, sink);
            float lsum = 0.f;
#pragma unroll
            for (int n = 0; n < 9; ++n)
#pragma unroll
                for (int j = 0; j < 4; ++j) { const float pz = __expf(sc[n][j] - mm); sc[n][j] = pz; lsum += pz; }
            lsum += __shfl_xor(lsum, 16); lsum += __shfl_xor(lsum, 32);
            lsum += __expf(sink - mm);
            const float inv = 1.0f / lsum;
            f32x4 o[4];
#pragma unroll
            for (int dt = 0; dt < 4; ++dt) o[dt] = (f32x4){0.f, 0.f, 0.f, 0.f};
            {
                const unsigned vbase = (unsigned)(size_t)(Vt + (16 * mt + 4 * fq + (fr >> 2)) * 72 + 4 * (fr & 3));
#define AT_PV(q_, OA_, OB_) do { u32x2 lo[4], hi[4]; tr_read8<OA_, OB_>(vbase, lo, hi); \
                u32x4 pku; pku[0] = pk2(sc[2 * (q_)][0], sc[2 * (q_)][1]); pku[1] = pk2(sc[2 * (q_)][2], sc[2 * (q_)][3]); \
                if (2 * (q_) + 1 < 9) { pku[2] = pk2(sc[(2 * (q_) + 1) % 9][0], sc[(2 * (q_) + 1) % 9][1]); pku[3] = pk2(sc[(2 * (q_) + 1) % 9][2], sc[(2 * (q_) + 1) % 9][3]); } else { pku[2] = 0u; pku[3] = 0u; } \
                const bf16x8 P = __builtin_bit_cast(bf16x8, pku); \
                _Pragma("unroll") for (int dt = 0; dt < 4; ++dt) { const u32x4 au = {lo[dt][0], lo[dt][1], hi[dt][0], hi[dt][1]}; o[dt] = mfma16(__builtin_bit_cast(bf16x8, au), P, o[dt]); } } while (0)
                AT_PV(0, 0, 2304); AT_PV(1, 4608, 6912); AT_PV(2, 9216, 11520); AT_PV(3, 13824, 16128); AT_PV(4, 18432, 18432);
#undef AT_PV
            }
#pragma unroll
            for (int dt = 0; dt < 4; ++dt) {
                const int d0 = hq * 64 + 16 * dt + 4 * fq;
                const u32x2 gate = gcur[dt];
                const float o0 = o[dt][0] * inv * bf_lo(gate[0]), o1 = o[dt][1] * inv * bf_hi(gate[0]), o2 = o[dt][2] * inv * bf_lo(gate[1]), o3 = o[dt][3] * inv * bf_hi(gate[1]);
                u32x2 pk = {pk2(o0, o1), pk2(o2, o3)};
                *(u32x2*)(GB + qrow * 1024 + d0) = pk;
            }
        }
        __syncthreads();
    }
#undef AT_LOAD_KV
#undef AT_LOAD_Q
}

#define XB_TMO      128
#define XB_XCNT(j)  (256  + 64 * (j))
#define XB_XSUB(j)  (1280 + 64 * (j))
#define XB_XGEN(j)  (2304 + 64 * (j))
#define XB_TOP      3328
#define XB_TOPGEN   3392
#define XCD_BAR_WORDS 3456
#define XB_SPIN_CAP (1u << 18)

__device__ __forceinline__ unsigned xb_ld(unsigned* p)              { return __hip_atomic_load(p, __ATOMIC_RELAXED, __HIP_MEMORY_SCOPE_AGENT); }
__device__ __forceinline__ unsigned xb_add(unsigned* p, unsigned v) { return __hip_atomic_fetch_add(p, v, __ATOMIC_RELAXED, __HIP_MEMORY_SCOPE_AGENT); }
__device__ __forceinline__ unsigned xb_xcc_id() { return (unsigned)__builtin_amdgcn_s_getreg((3 << 11) | 20) & 0xFu; }
#define XB_SPIN(cond, bar) do { unsigned _sp = 0; while (cond) { __builtin_amdgcn_s_sleep(1); \
    if ((++_sp & 255u) == 0u) { if (xb_ld(&(bar)[XB_TMO])) break; if (_sp > XB_SPIN_CAP) { atomicAdd(&(bar)[XB_TMO], 1u); break; } } } } while (0)

struct XcdBarrier {
    unsigned* bar; unsigned x;
    volatile LAS unsigned* st;
};

__device__ __forceinline__ XcdBarrier xcd_barrier_post(unsigned* bar, volatile LAS unsigned* st) {
    XcdBarrier b; b.bar = bar; b.x = xb_xcc_id(); b.st = st;
    if (threadIdx.x == 0) (void)xb_add(&bar[XB_XCNT(b.x)], 1u);
    return b;
}
__device__ __forceinline__ void xcd_barrier_complete(unsigned* bar, unsigned x, unsigned& nloc, unsigned& nx) {
    const unsigned G = gridDim.x * gridDim.y * gridDim.z;
    unsigned sum, cnt, mine, sp = 0u;
    for (;;) {
        sum = 0u; cnt = 0u; mine = 0u;
#pragma unroll
        for (unsigned j = 0; j < 16; ++j) { const unsigned c = xb_ld(&bar[XB_XCNT(j)]); sum += c; cnt += (c > 0u) ? 1u : 0u; mine = (j == x) ? c : mine; }
        if (sum == G) break;
        __builtin_amdgcn_s_sleep(1);
        if ((++sp & 255u) == 0u) { if (xb_ld(&bar[XB_TMO])) break; if (sp > XB_SPIN_CAP) { atomicAdd(&bar[XB_TMO], 1u); break; } }
    }
    nloc = mine > 0u ? mine : 1u; nx = cnt > 0u ? cnt : 1u;
}

__device__ __forceinline__ void xcd_barrier(const XcdBarrier& b) {
    asm volatile("s_waitcnt vmcnt(0)" ::: "memory");
    __syncthreads();
    if (threadIdx.x == 0) {
        unsigned* bar = b.bar;
        __builtin_amdgcn_s_waitcnt(0);
        unsigned nloc = b.st[0], nx = b.st[1];
        if (nloc == 0u) { xcd_barrier_complete(bar, b.x, nloc, nx); b.st[0] = nloc; b.st[1] = nx; }
        const unsigned old = xb_add(&bar[XB_XSUB(b.x)], 1u);
        const unsigned gen = old / nloc;
        if (old + 1u == (gen + 1u) * nloc) {
            __builtin_amdgcn_fence(__ATOMIC_RELEASE, "agent");
            asm volatile("s_waitcnt vmcnt(0)" ::: "memory");
            const unsigned og = xb_add(&bar[XB_TOP], 1u);
            const unsigned tg = og / nx;
            if (og + 1u == (tg + 1u) * nx) xb_add(&bar[XB_TOPGEN], 1u);
            else XB_SPIN(xb_ld(&bar[XB_TOPGEN]) == tg, bar);
            __builtin_amdgcn_fence(__ATOMIC_ACQUIRE, "agent");
            xb_add(&bar[XB_XGEN(b.x)], 1u);
            asm volatile("s_waitcnt vmcnt(0)" ::: "memory");
        } else {
            XB_SPIN(xb_ld(&bar[XB_XGEN(b.x)]) == gen, bar);
            __builtin_amdgcn_fence(__ATOMIC_ACQUIRE, "agent");
            asm volatile("s_waitcnt vmcnt(0)" ::: "memory");
        }
    }
    __syncthreads();
}


DI void stagger(int wg, int S, unsigned ticks) {
    const unsigned grp = (unsigned)(wg >> 3) % (unsigned)S;
    if (grp) { const unsigned long long t0 = __builtin_amdgcn_s_memrealtime(), d = (unsigned long long)grp * ticks; while (__builtin_amdgcn_s_memrealtime() - t0 < d) __builtin_amdgcn_s_sleep(16); }
}
__global__ void __launch_bounds__(512, 2) mega_fwd(Params p) {
    extern __shared__ __attribute__((aligned(16))) unsigned char smem[];
    LAS unsigned char* lds = (LAS unsigned char*)smem;
    cg::grid_group grid = cg::this_grid();
    const int wg = blockIdx.x, nwg = gridDim.x, tid = otid();
    unsigned char* ws = p.ws;
    LAS unsigned* stw = (LAS unsigned*)(lds + LDS_BYTES - 16);
    if (tid < 4) stw[tid] = 0u;
    __syncthreads();
    const XcdBarrier bar = xcd_barrier_post((unsigned*)(ws + WS_BAR), (volatile LAS unsigned*)stw);
#define GSYNC() xcd_barrier(bar)
    bf16_t* WIN = (bf16_t*)(ws + WS_WIN); bf16_t* WPA = (bf16_t*)(ws + WS_WPA); bf16_t* WPB = (bf16_t*)(ws + WS_WPB); bf16_t* WPC = (bf16_t*)(ws + WS_WPC); bf16_t* WOUT = (bf16_t*)(ws + WS_WOUT);
    bf16_t* U = (bf16_t*)(ws + WS_U); bf16_t* US = (bf16_t*)(ws + WS_US); float* X = (float*)(ws + WS_X); bf16_t* XB = (bf16_t*)(ws + WS_XB);
    bf16_t* GA = (bf16_t*)(ws + WS_GA); bf16_t* GB = (bf16_t*)(ws + WS_GB); bf16_t* GC = (bf16_t*)(ws + WS_GC); bf16_t* MG = (bf16_t*)(ws + WS_MG);
    bf16_t* DS = (bf16_t*)(ws + WS_DS); bf16_t* SIN = (bf16_t*)(ws + WS_SIN); float* DEC = (float*)(ws + WS_DEC); float* LB = (float*)(ws + WS_LB); float* BIAS = (float*)(ws + WS_BIAS);

#pragma unroll 1
    for (int rep = 0; rep < REP_PRO; ++rep) {
    for (size_t i = (size_t)wg * 512 + tid; i < (size_t)M_ * D_ / 4; i += (size_t)nwg * 512) {
        const f32x4 v = *(const f32x4*)(p.x + i * 4);
        u32x2 pk = {pk2(v[0], v[1]), pk2(v[2], v[3])};
        *(u32x2*)(XB + i * 4) = pk;
    }
    {
        const int gt = wg * 512 + tid;
        if (gt < 1024) {
            const float a0 = p.lb_param[gt], a1 = p.lb_param[1024 + gt], a2 = p.lb_param[2048 + gt], a3 = p.lb_param[3072 + gt];
            const float mx = fmaxf(fmaxf(a0, a1), fmaxf(a2, a3));
            const float e0 = expf(a0 - mx), e1 = expf(a1 - mx), e2 = expf(a2 - mx), e3 = expf(a3 - mx);
            const float inv = 1.0f / (e0 + e1 + e2 + e3);
            LB[gt] = 0.f; LB[1024 + gt] = e1 * inv; LB[2048 + gt] = (e1 + e2) * inv; LB[3072 + gt] = (e1 + e2 + e3) * inv;
        } else if (gt < 1024 + 2048) {
            const int hh = (gt - 1024) >> 7, rel = (gt - 1024) & 127;
            int bucket = rel;
            if (rel >= 16) { const float logd = logf((float)rel / 16.0f) / logf(8.0f); int lg = 16 + (int)(logd * 16.0f); bucket = lg > 31 ? 31 : lg; }
            BIAS[hh * 128 + rel] = p.rel_bias[bucket * 16 + hh];
        }
    }
#pragma unroll 1
    for (int l = 0; l < DEPTH_; ++l) convert_layer_weights(lds, p, ws, l, wg, nwg, (HIDE_CVT && l > 0) ? 2 : 0);
    }
    if (p.out == nullptr) grid.sync();
    GSYNC();

    unsigned long long tacc = 0ull, tq0 = 0ull;
#define TQ_BEGIN(id) do { if (PROBE_ID == (id)) tq0 = __builtin_amdgcn_s_memrealtime(); } while (0)
#define TQ_END(id) do { if (PROBE_ID == (id)) tacc += __builtin_amdgcn_s_memrealtime() - tq0; } while (0)
#pragma unroll 1
    for (int l = 0; l < DEPTH_; ++l) {
#pragma unroll 1
        for (int rep = 0; rep < REP_GIN; ++rep) {
            stagger(wg, STG_IN_S, STG_IN_T);
            pg8::Gemm g; g.A = XB; g.Bt = WIN + (size_t)l * NIN_ * D_; g.M = M_; g.N = NIN_; g.K = D_;
            pg8::StaticOrder S; S.init(M_, NIN_, nwg, wg);
            EpiIn E; E.U = U; E.lb = LB + l * 1024; E.GT = (bf16_t*)(ws + WS_GT); E.US = (bf16_t*)(ws + WS_US);
            pg8::gemm_phase<EpiIn, pg8::StaticOrder, false>(lds, g, S, E, nullptr);
            if (HIDE_CVT && rep == 0 && l + 1 < DEPTH_) {
                const int rem = ((M_ / 256) * (NIN_ / 256)) % nwg;
                const int tw = rem == 0 ? wg : wg - rem, tn = rem == 0 ? nwg : nwg - rem;
                if (tw >= 0) convert_layer_weights(lds, p, ws, l + 1, tw, tn, 1);
            }
        }
        GSYNC();
        TQ_BEGIN(1); TQ_BEGIN(2);
#pragma unroll 1
        for (int rep = 0; rep < REP_P2; ++rep) {
        hgrn_local_phase(lds, US, DS, DEC, wg, nwg);
        TQ_END(2); TQ_BEGIN(3);
        attn_phase(lds, US, GB, BIAS, p.sinks + l * 16, wg, nwg);
        TQ_END(3); TQ_BEGIN(4);
        conv_phase(U, U + (size_t)M_ * 1024, GC, p.conv_w + (size_t)l * 3 * 1024, wg, nwg);
        TQ_END(4);
        }
        GSYNC();
        TQ_END(1); TQ_BEGIN(5);
#pragma unroll 1
        for (int rep = 0; rep < REP_SCAN; ++rep)
        hgrn_scan_phase(lds, DS, DEC, SIN, wg, nwg);
        GSYNC();
        TQ_END(5); TQ_BEGIN(6);
#pragma unroll 1
        for (int rep = 0; rep < REP_H3; ++rep)
        hgrn_out_phase(lds, US, SIN, GA, p.norm_g + l * 1024, wg, nwg);
        GSYNC();
        TQ_END(6);
        stagger(wg, STG_MG_S, STG_MG_T);
#pragma unroll 1
        for (int br = 0; br < 3 * REP_MG; ++br) {
            pg8::Gemm g; const int bq = br % 3; g.A = bq == 0 ? GA : (bq == 1 ? GB : GC); g.Bt = (bq == 0 ? WPA : (bq == 1 ? WPB : WPC)) + (size_t)l * D_ * 1024; g.M = M_; g.N = D_; g.K = 1024;
            pg8::StaticOrder S; S.init(M_, D_, nwg, wg);
            EpiMerge E; E.GTb = (const unsigned char*)(ws + WS_GT) + (size_t)bq * 512 * 65536; E.MP = (bf16_t*)(ws + WS_MP); E.Mg = MG; E.br = bq;
            pg8::gemm_phase<EpiMerge, pg8::StaticOrder, false>(lds, g, S, E, nullptr);
        }
        GSYNC();
        {
            pg8::Gemm g; g.A = MG; g.Bt = WOUT + (size_t)l * D_ * D_; g.M = M_; g.N = D_; g.K = D_;
            pg8::StaticOrder S; S.init(M_, D_, nwg, wg);
            EpiOut E; E.Y = GA;
            pg8::gemm_phase<EpiOut, pg8::StaticOrder, false>(lds, g, S, E, nullptr);
        }
        GSYNC();
        if (l == 0) ln_phase<true, false>(p.x, GA, p.out, XB, (unsigned char*)X, p.ln_g + l * D_, p.ln_b + l * D_, wg, nwg);
        else if (l == DEPTH_ - 1) ln_phase<false, true>(p.x, GA, p.out, XB, (unsigned char*)X, p.ln_g + l * D_, p.ln_b + l * D_, wg, nwg);
        else ln_phase<false, false>(p.x, GA, p.out, XB, (unsigned char*)X, p.ln_g + l * D_, p.ln_b + l * D_, wg, nwg);
        if (l != DEPTH_ - 1) GSYNC();
#pragma unroll 1
        for (int rep = 0; rep < REP_SYNC; ++rep) GSYNC();
    }
    if (PROBE_ID != 0) { GSYNC(); const unsigned long long t0 = __builtin_amdgcn_s_memrealtime(), d = tacc * PROBE_AMP; while (__builtin_amdgcn_s_memrealtime() - t0 < d) __builtin_amdgcn_s_sleep(32); }
}

extern "C" void kernel_launch(void* const* d_in, const int* in_sizes, int n_in, void* d_out, int out_size, void* d_ws, size_t ws_size, hipStream_t stream) {
    static int grid_blocks = 0;
    if (grid_blocks == 0) {
        if (n_in != 13 || out_size != M_ * D_ || ws_size < WS_END) { fprintf(stderr, "kernel_launch: unexpected shapes (n_in %d out %d ws %zu need %zu)\n", n_in, out_size, ws_size, (size_t)WS_END); grid_blocks = -1; return; }
        int dev = 0, cus = 0, per_cu = 0;
        hipGetDevice(&dev);
        hipDeviceGetAttribute(&cus, hipDeviceAttributeMultiprocessorCount, dev);
        if (hipFuncSetAttribute((const void*)mega_fwd, hipFuncAttributeMaxDynamicSharedMemorySize, LDS_BYTES) != hipSuccess) { fprintf(stderr, "kernel_launch: hipFuncSetAttribute failed\n"); grid_blocks = -1; return; }
        if (hipOccupancyMaxActiveBlocksPerMultiprocessor(&per_cu, (const void*)mega_fwd, 512, LDS_BYTES) != hipSuccess || per_cu < 1) { fprintf(stderr, "kernel_launch: occupancy query gave %d\n", per_cu); per_cu = 1; }
        (void)hipGetLastError();
        grid_blocks = cus * per_cu;
    }
    if (grid_blocks < 0) return;
    Params p{};
    p.x = (const float*)d_in[0]; p.w_in = (const float*)d_in[1]; p.w_pa = (const float*)d_in[2]; p.w_pb = (const float*)d_in[3]; p.w_pc = (const float*)d_in[4];
    p.w_out = (const float*)d_in[5]; p.lb_param = (const float*)d_in[6]; p.norm_g = (const float*)d_in[7]; p.sinks = (const float*)d_in[8]; p.conv_w = (const float*)d_in[9];
    p.rel_bias = (const float*)d_in[10]; p.ln_g = (const float*)d_in[11]; p.ln_b = (const float*)d_in[12];
    p.out = (float*)d_out; p.ws = (unsigned char*)d_ws;
    if (hipMemsetAsync((unsigned char*)d_ws + WS_BAR, 0, 16384, stream) != hipSuccess) { fprintf(stderr, "kernel_launch: memset of barrier words failed\n"); return; }
    void* args[] = {&p};
    hipError_t e = hipLaunchCooperativeKernel((const void*)mega_fwd, dim3(grid_blocks), dim3(512), args, LDS_BYTES, stream);
    if (e != hipSuccess) fprintf(stderr, "cooperative launch failed: %s (grid %d)\n", hipGetErrorString(e), grid_blocks);
}
```
